# Optimizing an MI355X kernel written in HIP

```python
import math
import jax
import jax.numpy as jnp
from jax import lax
import numpy as np

D_MODEL = 1024
BATCH = 8
SEQ = 4096
DEPTH = 2

D_MIX = D_MODEL
D_CONV = D_MIX // 2
D_ATTN = D_MIX - D_CONV
HEAD_DIM = 64
N_HEADS = D_ATTN // HEAD_DIM
CONV_K = 3
IN_COLS = 3 * D_CONV + 3 * D_ATTN
QBLK = 128
N_EXPERTS = 32
N_GROUPS = 8
EXPERTS_PER_GROUP = N_EXPERTS // N_GROUPS
TOP_K = 2
D_EXPERT = 512
MOE_BLK = 128
DEEPNORM_ALPHA = (2.0 * DEPTH) ** 0.25
DEEPNORM_BETA = (8.0 * DEPTH) ** -0.25
LN_EPS = 1e-5
RMS_EPS = 1e-6

kernel_name = "hybrid_conv_stickbreaking_sharedrouter_moe_deepnorm"


def layer_norm(x, g, b):
    xf = x.astype(jnp.float32)
    mu = jnp.mean(xf, axis=-1, keepdims=True)
    var = jnp.mean(jnp.square(xf - mu), axis=-1, keepdims=True)
    y = (xf - mu) * lax.rsqrt(var + LN_EPS) * g.astype(jnp.float32) + b.astype(jnp.float32)
    return y.astype(x.dtype)


def rms_norm(x, g):
    xf = x.astype(jnp.float32)
    y = xf * lax.rsqrt(jnp.mean(jnp.square(xf), axis=-1, keepdims=True) + RMS_EPS)
    return (y * g.astype(jnp.float32)).astype(x.dtype)


def causal_short_conv(u, w):
    c = u.shape[-1]
    return lax.conv_general_dilated(
        u, w[:, None, :].astype(u.dtype), window_strides=(1,),
        padding=((CONV_K - 1, 0),), dimension_numbers=("NWC", "WIO", "NWC"),
        feature_group_count=c)


def stick_breaking_attention(q, k, v):
    bsz, s, _ = q.shape
    nb = s // QBLK
    scale = 1.0 / math.sqrt(HEAD_DIM)
    qh = q.reshape(bsz, s, N_HEADS, HEAD_DIM).transpose(0, 2, 1, 3)
    kf = k.reshape(bsz, s, N_HEADS, HEAD_DIM).transpose(0, 2, 1, 3).astype(jnp.float32)
    vf = v.reshape(bsz, s, N_HEADS, HEAD_DIM).transpose(0, 2, 1, 3).astype(jnp.float32)
    qb = qh.reshape(bsz, N_HEADS, nb, QBLK, HEAD_DIM).transpose(2, 0, 1, 3, 4)
    kpos = jnp.arange(s)

    def block(args):
        qblk, i = args
        z = jnp.einsum("bhqd,bhkd->bhqk", qblk.astype(jnp.float32), kf) * scale
        qpos = i * QBLK + jnp.arange(QBLK)
        mask = kpos[None, :] < qpos[:, None]
        log_keep = jnp.where(mask, jax.nn.log_sigmoid(-z), 0.0)
        suffix = lax.cumsum(log_keep, axis=3, reverse=True) - log_keep
        a = jnp.where(mask, jnp.exp(jax.nn.log_sigmoid(z) + suffix), 0.0)
        return jnp.einsum("bhqk,bhkd->bhqd", a, vf)

    o = lax.map(block, (qb, jnp.arange(nb)))
    o = o.transpose(1, 0, 3, 2, 4).reshape(bsz, s, D_ATTN)
    return o.astype(q.dtype)


def route(h, router_w, router_b):
    t = h.shape[0]
    scores = jax.nn.sigmoid(jnp.matmul(h, router_w).astype(jnp.float32))
    sel = (scores + router_b.astype(jnp.float32)).reshape(t, N_GROUPS, EXPERTS_PER_GROUP)
    group_score = lax.top_k(sel, 2)[0].sum(-1)
    g = jnp.argmax(group_score, axis=-1)
    in_group = jnp.take_along_axis(sel, g[:, None, None], axis=1)[:, 0]
    _, local = lax.top_k(in_group, TOP_K)
    eidx = g[:, None] * EXPERTS_PER_GROUP + local
    w = jnp.take_along_axis(scores, eidx, axis=1)
    w = w / jnp.sum(w, axis=-1, keepdims=True)
    return eidx, w


def moe(h, router_w, router_b, w_gate, w_up, w_down):
    t, d = h.shape
    eidx, w = route(h, router_w, router_b)
    n = t * TOP_K
    flat_e = eidx.reshape(n)
    flat_t = jnp.repeat(jnp.arange(t, dtype=jnp.int32), TOP_K, total_repeat_length=n)
    flat_w = w.reshape(n)
    order = jnp.argsort(flat_e)
    se, st, sw = flat_e[order], flat_t[order], flat_w[order]
    counts = jnp.zeros((N_EXPERTS,), jnp.int32).at[flat_e].add(1)
    starts = jnp.cumsum(counts) - counts
    padded = (counts + MOE_BLK - 1) // MOE_BLK * MOE_BLK
    pends = jnp.cumsum(padded)
    pstarts = pends - padded
    dest = pstarts[se] + jnp.arange(n, dtype=jnp.int32) - starts[se]
    rows = (n + N_EXPERTS * (MOE_BLK - 1) + MOE_BLK - 1) // MOE_BLK * MOE_BLK
    nblk = rows // MOE_BLK
    buf_t = jnp.full((rows,), t, jnp.int32).at[dest].set(st)
    buf_w = jnp.zeros((rows,), jnp.float32).at[dest].set(sw)
    blk_e = jnp.clip(jnp.searchsorted(pends, jnp.arange(nblk) * MOE_BLK, side="right"),
                     0, N_EXPERTS - 1)
    hp = jnp.concatenate([h, jnp.zeros((1, d), h.dtype)], axis=0)
    xb = hp[buf_t].reshape(nblk, MOE_BLK, d)

    def expert_block(args):
        xblk, e = args
        a = jnp.matmul(xblk, w_gate[e])
        u = jnp.matmul(xblk, w_up[e])
        return jnp.matmul(jax.nn.silu(a) * u, w_down[e])

    yb = lax.map(expert_block, (xb, blk_e)).reshape(rows, d)
    out = jnp.zeros((t + 1, d), h.dtype).at[buf_t].add(yb * buf_w[:, None].astype(h.dtype))
    return out[:t]


def setup_inputs(seed: int = 0) -> dict:
    key = jax.random.key(seed)
    ks = jax.random.split(key, 18)
    nrm = jax.random.normal
    f32 = jnp.float32
    return {
        "x": nrm(ks[0], (BATCH, SEQ, D_MODEL), f32),
        "ln0_g": 1.0 + 0.02 * nrm(ks[1], (D_MODEL,), f32),
        "ln0_b": 0.02 * nrm(ks[2], (D_MODEL,), f32),
        "w_in": nrm(ks[3], (DEPTH, D_MODEL, IN_COLS), f32) * D_MODEL ** -0.5,
        "conv_w": nrm(ks[4], (DEPTH, CONV_K, D_CONV), f32) * CONV_K ** -0.5,
        "g_conv": 1.0 + 0.02 * nrm(ks[5], (DEPTH, D_CONV), f32),
        "g_attn": 1.0 + 0.02 * nrm(ks[6], (DEPTH, D_ATTN), f32),
        "w_out": nrm(ks[7], (DEPTH, D_MIX, D_MODEL), f32) * (D_MIX ** -0.5 * DEEPNORM_BETA),
        "ln_mix_g": 1.0 + 0.02 * nrm(ks[8], (DEPTH, D_MODEL), f32),
        "ln_mix_b": 0.02 * nrm(ks[9], (DEPTH, D_MODEL), f32),
        "router_w": nrm(ks[10], (D_MODEL, N_EXPERTS), f32) * D_MODEL ** -0.5,
        "router_b": 0.01 * nrm(ks[11], (N_EXPERTS,), f32),
        "w_gate": nrm(ks[12], (DEPTH, N_EXPERTS, D_MODEL, D_EXPERT), f32) * D_MODEL ** -0.5,
        "w_up": nrm(ks[13], (DEPTH, N_EXPERTS, D_MODEL, D_EXPERT), f32) * D_MODEL ** -0.5,
        "w_down": nrm(ks[14], (DEPTH, N_EXPERTS, D_EXPERT, D_MODEL), f32) * (D_EXPERT ** -0.5 * DEEPNORM_BETA),
        "ln_ffn_g": 1.0 + 0.02 * nrm(ks[15], (DEPTH, D_MODEL), f32),
        "ln_ffn_b": 0.02 * nrm(ks[16], (DEPTH, D_MODEL), f32),
    }


def reference(x, ln0_g, ln0_b, w_in, conv_w, g_conv, g_attn, w_out, ln_mix_g, ln_mix_b,
              router_w, router_b, w_gate, w_up, w_down, ln_ffn_g, ln_ffn_b):
    bsz, s, d = x.shape
    h = layer_norm(x, ln0_g, ln0_b)
    for l in range(DEPTH):
        proj = jnp.matmul(h, w_in[l])
        cb, cc, cx, q, k, v = jnp.split(
            proj, [D_CONV, 2 * D_CONV, 3 * D_CONV, 3 * D_CONV + D_ATTN,
                   3 * D_CONV + 2 * D_ATTN], axis=-1)
        conv_out = cb * causal_short_conv(cc * cx, conv_w[l])
        attn_out = stick_breaking_attention(q, k, v)
        mixed = jnp.concatenate([rms_norm(conv_out, g_conv[l]),
                                 rms_norm(attn_out, g_attn[l])], axis=-1)
        mix = jnp.matmul(mixed, w_out[l])
        h = layer_norm(DEEPNORM_ALPHA * h + mix, ln_mix_g[l], ln_mix_b[l])
        ffn = moe(h.reshape(bsz * s, d), router_w, router_b,
                  w_gate[l], w_up[l], w_down[l]).reshape(bsz, s, d)
        h = layer_norm(DEEPNORM_ALPHA * h + ffn, ln_ffn_g[l], ln_ffn_b[l])
    return h
```

```cpp
#include <hip/hip_runtime.h>
#include <cstdint>
#include <cstdio>
#ifndef PROBE_MASK
#define PROBE_MASK 0
#endif
#ifndef MK_MODE
#define MK_MODE 1
#endif

constexpr int T = 32768, D = 1024, SEQ = 4096, NBATCH = 8, DEPTH = 2;
constexpr int DC = 512, DA = 512, HD = 64, NH = 8, NPROJ = 3072;
constexpr int NE = 32, NG = 8, EPG = 4, DEXP = 512;
constexpr float ALPHA = 1.41421356237f;
constexpr float LN_EPS = 1e-5f, RMS_EPS = 1e-6f;
constexpr float Y_SCALE = 16.f;
constexpr float QSCALE = 0.125f * 1.4426950408889634f;
constexpr float LN2 = 0.6931471805599453f;
constexpr int PP = 2560, PO_Q = 0, PO_B = 512, PO_U = 1024, PO_K = 1536, PO_V = 2048;

constexpr size_t MiB = 1u << 20;
constexpr size_t WS_CTL = 0, CTL_BYTES = 1 * MiB;
constexpr size_t WS_ROUTE = 1 * MiB;
constexpr size_t WS_LIST = 2 * MiB;
constexpr size_t WS_WIN = 6 * MiB, WS_WOUT = 18 * MiB, WS_WGU = 22 * MiB, WS_WD = 150 * MiB;
constexpr size_t WS_PROJ = 214 * MiB;
constexpr size_t WS_HB = 406 * MiB;
constexpr size_t WS_H1B = 470 * MiB;
constexpr size_t WS_STATP = 534 * MiB;
constexpr size_t WS_WRT = 538 * MiB;
constexpr size_t WS_SSQ = 539 * MiB;
constexpr size_t WS_END = 540 * MiB;
constexpr size_t WS_Y = WS_PROJ;
constexpr size_t WS_HID = WS_PROJ + 144 * MiB;
constexpr int CW_CNT = 1024;

typedef unsigned short bf16_t;
typedef float f32x4 __attribute__((ext_vector_type(4)));
typedef unsigned u32x4 __attribute__((ext_vector_type(4)));
typedef unsigned u32x2 __attribute__((ext_vector_type(2)));

__device__ __forceinline__ unsigned f2bf(float f) { unsigned u = __builtin_bit_cast(unsigned, f); return (u + 0x7fffu + ((u >> 16) & 1u)) >> 16; }
__device__ __forceinline__ float bf2f(unsigned b) { return __builtin_bit_cast(float, b << 16); }
typedef float f32x2_pk __attribute__((ext_vector_type(2))); typedef __bf16 bf16x2_pk __attribute__((ext_vector_type(2)));
__device__ __forceinline__ unsigned pk2(float lo, float hi) { f32x2_pk v = {lo, hi}; bf16x2_pk b = __builtin_convertvector(v, bf16x2_pk); return __builtin_bit_cast(unsigned, b); }
#define DPP_ADD(v, ctrl) ((v) + __builtin_bit_cast(float, __builtin_amdgcn_update_dpp(0, __builtin_bit_cast(int, (v)), (ctrl), 0xf, 0xf, false)))
__device__ __forceinline__ float wave_sum(float v) {
    v = DPP_ADD(v, 0xB1); v = DPP_ADD(v, 0x4E); v = DPP_ADD(v, 0x141); v = DPP_ADD(v, 0x140);
    const int iv = __builtin_bit_cast(int, v);
    const float r0 = __builtin_bit_cast(float, __builtin_amdgcn_readlane(iv, 0)), r1 = __builtin_bit_cast(float, __builtin_amdgcn_readlane(iv, 16)),
                r2 = __builtin_bit_cast(float, __builtin_amdgcn_readlane(iv, 32)), r3 = __builtin_bit_cast(float, __builtin_amdgcn_readlane(iv, 48));
    return (r0 + r1) + (r2 + r3);
}

struct Ptrs {
    const float *x, *ln0_g, *ln0_b, *w_in, *conv_w, *g_conv, *g_attn, *w_out, *ln_mix_g, *ln_mix_b, *router_w, *router_b, *w_gate, *w_up, *w_down, *ln_ffn_g, *ln_ffn_b;
    float* out; unsigned char* ws;
};

__device__ __forceinline__ void unpack8(const u32x4 v, float* f) {
    f[0] = bf2f(v.x & 0xffffu); f[1] = bf2f(v.x >> 16); f[2] = bf2f(v.y & 0xffffu); f[3] = bf2f(v.y >> 16);
    f[4] = bf2f(v.z & 0xffffu); f[5] = bf2f(v.z >> 16); f[6] = bf2f(v.w & 0xffffu); f[7] = bf2f(v.w >> 16);
}


#define GAS __attribute__((address_space(1)))
#define LAS __attribute__((address_space(3)))
typedef short bf16x8 __attribute__((ext_vector_type(8)));
typedef GAS unsigned gu32;
#define RLX_AGENT __ATOMIC_RELAXED, __HIP_MEMORY_SCOPE_AGENT
#define LDS_WAIT() asm volatile("s_waitcnt lgkmcnt(0)" ::: "memory")
#define VM_WAIT() asm volatile("s_waitcnt vmcnt(0)" ::: "memory")

constexpr int NWAVES = 8;
constexpr int RING_BYTES = 131072;
constexpr int LDSCTL_OFF = RING_BYTES;
constexpr int MISC_OFF = LDSCTL_OFF + 64;
constexpr int TAB_OFF = LDSCTL_OFF + 256;
constexpr int TOKT_OFF = RING_BYTES + 8192;
constexpr int LDS_BYTES = 163840;
constexpr int CW_BAR = 4096;
constexpr int N_PHASES = 1 + 7 * DEPTH;

__device__ __forceinline__ int lane_id_v() { int l; asm volatile("v_mbcnt_lo_u32_b32 %0, -1, 0\n\tv_mbcnt_hi_u32_b32 %0, -1, %0" : "=v"(l)); return l; }
#define XB_TMO      128
#define XB_XCNT(j)  (256  + 64 * (j))
#define XB_XSUB(j)  (1280 + 64 * (j))
#define XB_XGEN(j)  (2304 + 64 * (j))
#define XB_TOP      3328
#define XB_TOPGEN   3392
#define XCD_BAR_WORDS 3456
#define XB_SPIN_CAP (1u << 18)
__device__ __forceinline__ unsigned xb_ld(unsigned* p)              { return __hip_atomic_load(p, __ATOMIC_RELAXED, __HIP_MEMORY_SCOPE_AGENT); }
__device__ __forceinline__ unsigned xb_add(unsigned* p, unsigned v) { return __hip_atomic_fetch_add(p, v, __ATOMIC_RELAXED, __HIP_MEMORY_SCOPE_AGENT); }
__device__ __forceinline__ unsigned xb_xcc_id() { return (unsigned)__builtin_amdgcn_s_getreg((3 << 11) | 20) & 0xFu; }
#define XB_SPIN(cond, bar) do { unsigned _sp = 0; while (cond) { __builtin_amdgcn_s_sleep(1); \
    if ((++_sp & 255u) == 0u) { if (xb_ld(&(bar)[XB_TMO])) break; if (_sp > XB_SPIN_CAP) { atomicAdd(&(bar)[XB_TMO], 1u); break; } } } } while (0)
struct XcdBarrier { unsigned* bar; unsigned x; volatile LAS unsigned* st; };
__device__ __forceinline__ XcdBarrier xcd_barrier_post(unsigned* bar, volatile LAS unsigned* st) {
    XcdBarrier b; b.bar = bar; b.x = xb_xcc_id(); b.st = st;
    if (threadIdx.x == 0) (void)xb_add(&bar[XB_XCNT(b.x)], 1u);
    return b;
}
__device__ __forceinline__ void xcd_barrier_complete(unsigned* bar, unsigned x, unsigned& nloc, unsigned& nx) {
    const unsigned G = gridDim.x * gridDim.y * gridDim.z;
    unsigned sum, cnt, mine, sp = 0u;
    for (;;) {
        sum = 0u; cnt = 0u; mine = 0u;
#pragma unroll
        for (unsigned j = 0; j < 16; ++j) { const unsigned c = xb_ld(&bar[XB_XCNT(j)]); sum += c; cnt += (c > 0u) ? 1u : 0u; mine = (j == x) ? c : mine; }
        if (sum == G) break;
        __builtin_amdgcn_s_sleep(1);
        if ((++sp & 255u) == 0u) { if (xb_ld(&bar[XB_TMO])) break; if (sp > XB_SPIN_CAP) { atomicAdd(&bar[XB_TMO], 1u); break; } }
    }
    nloc = mine > 0u ? mine : 1u; nx = cnt > 0u ? cnt : 1u;
}
__device__ __forceinline__ void xcd_barrier(const XcdBarrier& b, const int wave_id  ) {
    asm volatile("s_waitcnt vmcnt(0)" ::: "memory");
    __syncthreads();
    if (wave_id == 0 && lane_id_v() == 0) {
        unsigned* bar = b.bar;
        __builtin_amdgcn_s_waitcnt(0);
        unsigned nloc = b.st[0], nx = b.st[1];
        if (nloc == 0u) { xcd_barrier_complete(bar, b.x, nloc, nx); b.st[0] = nloc; b.st[1] = nx; }
        const unsigned old = xb_add(&bar[XB_XSUB(b.x)], 1u);
        const unsigned gen = old / nloc;
        if (old + 1u == (gen + 1u) * nloc) {
            __builtin_amdgcn_fence(__ATOMIC_RELEASE, "agent");
            asm volatile("s_waitcnt vmcnt(0)" ::: "memory");
            const unsigned og = xb_add(&bar[XB_TOP], 1u);
            const unsigned tg = og / nx;
            if (og + 1u == (tg + 1u) * nx) xb_add(&bar[XB_TOPGEN], 1u);
            else XB_SPIN(xb_ld(&bar[XB_TOPGEN]) == tg, bar);
            __builtin_amdgcn_fence(__ATOMIC_ACQUIRE, "agent");
            xb_add(&bar[XB_XGEN(b.x)], 1u);
            asm volatile("s_waitcnt vmcnt(0)" ::: "memory");
        } else {
            XB_SPIN(xb_ld(&bar[XB_XGEN(b.x)]) == gen, bar);
            __builtin_amdgcn_fence(__ATOMIC_ACQUIRE, "agent");
            asm volatile("s_waitcnt vmcnt(0)" ::: "memory");
        }
    }
    __syncthreads();
}

namespace pg8 {
constexpr int BM = 256, BK = 64, HALF = 128, HTB = HALF * BK * 2, STAGE_BYTES = 8 * HTB, NXCD = 8, WGM = 8;
__host__ __device__ __forceinline__ int lds_byte(int r, int c) { const int st = (r >> 4) * 2 + (c >> 5), rr = r & 15, cc = c & 31, ob = rr * 64 + cc * 2; return st * 1024 + (ob ^ (((ob >> 9) & 1) << 5)); }
__host__ __device__ __forceinline__ void stage_rc(int b, int& R, int& C) { const int st = b / 1024, sb = b % 1024, swz = sb ^ (((sb >> 9) & 1) << 5); R = (st >> 1) * 16 + swz / 64; C = (st & 1) * 32 + (swz % 64) / 2; }
__host__ __device__ __forceinline__ int perm32(int rho) { const int n = rho >> 4, i = rho & 15; return 8 * (i >> 2) + 4 * n + (i & 3); }

struct Unit { int pm, pn; const char* a; const char* b; const int* rl; int nvalid; int row0; int half; int rlds; };

struct StaticOrder {          static constexpr bool HAS_HALF = false;
    int nM, nN, nwg, G, c, r0, r1; const char* A; const char* Bt; size_t astep, bstep;
    __device__ __forceinline__ void init(const void* A_, int lda, const void* Bt_, int M, int N, int K, int G_, int c_) { nM = M / BM; nN = N / BM; nwg = nM * nN; G = G_; c = c_; r0 = 0; r1 = 1 << 30; A = (const char*)A_; Bt = (const char*)Bt_; astep = (size_t)BM * lda * 2; bstep = (size_t)BM * K * 2; }
    __device__ __forceinline__ bool next(int i_, Unit& u) const {
        const int i = i_ + r0; if (i >= r1) return false;
        const long L = (long)i * G + c; if (L >= nwg) return false;
        int wgid = (int)L; { const int q = nwg / NXCD, r = nwg % NXCD, xcd = wgid % NXCD, off = wgid / NXCD; wgid = (xcd < r ? xcd * (q + 1) : r * (q + 1) + (xcd - r) * q) + off; }
        const int nig = WGM * nN, gid = wgid / nig, fm = gid * WGM, gsz = (nM - fm) < WGM ? (nM - fm) : WGM;
        u.pm = fm + ((wgid % nig) % gsz); u.pn = (wgid % nig) / gsz; u.a = A + (size_t)u.pm * astep; u.b = Bt + (size_t)u.pn * bstep; u.rl = nullptr; u.nvalid = 0; u.row0 = u.pm * BM; u.half = 0; u.rlds = 0; return true;
    }
};

typedef float f32x2_e __attribute__((ext_vector_type(2)));
__device__ __forceinline__ unsigned cvt_pk_bf16(float lo, float hi) { unsigned r; asm volatile("v_cvt_pk_bf16_f32 %0, %1, %2" : "=v"(r) : "v"(lo), "v"(hi)); return r; }

struct EpiStoreBf16 {
    static constexpr bool PERM = true;
    bf16_t* O; int ldc;
    __device__ __forceinline__ void operator()(const f32x4 (&acc)[2][2][4][2], const Unit& u, int wr, int wc, int fr, int fq) const {
        const int row0 = u.row0 + wr * 64 + fr, col0 = u.pn * BM + wc * 32 + 8 * fq;
#pragma unroll
        for (int ai = 0; ai < 2; ++ai)
#pragma unroll
            for (int m = 0; m < 4; ++m) { if (ai == 1 && u.half) continue; bf16_t* rowp = O + (size_t)(row0 + ai * HALF + m * 16) * ldc + col0;
#pragma unroll
                for (int bj = 0; bj < 2; ++bj) { const f32x4 v0 = acc[ai][bj][m][0], v1 = acc[ai][bj][m][1];
                    u32x4 w; w.x = cvt_pk_bf16(v0[0], v0[1]); w.y = cvt_pk_bf16(v0[2], v0[3]); w.z = cvt_pk_bf16(v1[0], v1[1]); w.w = cvt_pk_bf16(v1[2], v1[3]);
                    *(u32x4*)(rowp + bj * HALF) = w; } }
    }
};
struct EpiStoreFp8 {
    static constexpr bool PERM = true;
    unsigned char* O; int ldc; float scale;
    __device__ __forceinline__ void operator()(const f32x4 (&acc)[2][2][4][2], const Unit& u, int wr, int wc, int fr, int fq) const {
        const int row0 = u.row0 + wr * 64 + fr, col0 = u.pn * BM + wc * 32 + 8 * fq;
#pragma unroll
        for (int ai = 0; ai < 2; ++ai)
#pragma unroll
            for (int m = 0; m < 4; ++m) { if (ai == 1 && u.half) continue; unsigned char* rowp = O + (size_t)(row0 + ai * HALF + m * 16) * ldc + col0;
#pragma unroll
                for (int bj = 0; bj < 2; ++bj) { f32x4 v0 = acc[ai][bj][m][0] * scale, v1 = acc[ai][bj][m][1] * scale;
#pragma unroll
                    for (int q = 0; q < 4; ++q) { v0[q] = __builtin_fminf(__builtin_fmaxf(v0[q], -240.f), 240.f); v1[q] = __builtin_fminf(__builtin_fmaxf(v1[q], -240.f), 240.f); }
                    int w0 = __builtin_amdgcn_cvt_pk_fp8_f32(v0[0], v0[1], 0, false); w0 = __builtin_amdgcn_cvt_pk_fp8_f32(v0[2], v0[3], w0, true);
                    int w1 = __builtin_amdgcn_cvt_pk_fp8_f32(v1[0], v1[1], 0, false); w1 = __builtin_amdgcn_cvt_pk_fp8_f32(v1[2], v1[3], w1, true);
                    u32x2 w; w.x = (unsigned)w0; w.y = (unsigned)w1; *(u32x2*)(rowp + bj * HALF) = w; } }
    }
};
struct EpiInProj {
    static constexpr bool PERM = true;
    bf16_t* O; int ldc;
    __device__ __forceinline__ void operator()(const f32x4 (&acc)[2][2][4][2], const Unit& u, int wr, int wc, int fr, int fq) const {
        const int row0 = u.row0 + wr * 64 + fr;
        if (u.pn >= 4 && u.pn < 8) {
            const int col0 = 1024 + (u.pn - 4) * HALF + wc * 32 + 8 * fq;
#pragma unroll
            for (int ai = 0; ai < 2; ++ai)
#pragma unroll
                for (int m = 0; m < 4; ++m) { const f32x4 c0 = acc[ai][0][m][0], c1 = acc[ai][0][m][1], x0 = acc[ai][1][m][0], x1 = acc[ai][1][m][1];
                    u32x4 w; w.x = cvt_pk_bf16(c0[0] * x0[0], c0[1] * x0[1]); w.y = cvt_pk_bf16(c0[2] * x0[2], c0[3] * x0[3]); w.z = cvt_pk_bf16(c1[0] * x1[0], c1[1] * x1[1]); w.w = cvt_pk_bf16(c1[2] * x1[2], c1[3] * x1[3]);
                    *(u32x4*)(O + (size_t)(row0 + ai * HALF + m * 16) * ldc + col0) = w; }
        } else {
            const int col0 = (u.pn < 2 ? 512 + u.pn * BM : u.pn < 4 ? (u.pn - 2) * BM : 1536 + (u.pn - 8) * BM) + wc * 32 + 8 * fq;
#pragma unroll
            for (int ai = 0; ai < 2; ++ai)
#pragma unroll
                for (int m = 0; m < 4; ++m) { bf16_t* rowp = O + (size_t)(row0 + ai * HALF + m * 16) * ldc + col0;
#pragma unroll
                    for (int bj = 0; bj < 2; ++bj) { const f32x4 v0 = acc[ai][bj][m][0], v1 = acc[ai][bj][m][1];
                        u32x4 w; w.x = cvt_pk_bf16(v0[0], v0[1]); w.y = cvt_pk_bf16(v0[2], v0[3]); w.z = cvt_pk_bf16(v1[0], v1[1]); w.w = cvt_pk_bf16(v1[2], v1[3]);
                        *(u32x4*)(rowp + bj * HALF) = w; } }
        }
    }
};
struct EpiResBf16 {
    static constexpr bool PERM = true;
    const bf16_t* res; bf16_t* out; int ldc; float alpha; float* statp; const LAS float* ra;
    __device__ __forceinline__ void mid(f32x4 (&acc)[2][2][4][2], int ui, int wr, int fr) const {
#pragma unroll
        for (int ai = 0; ai < 2; ++ai)
#pragma unroll
            for (int m = 0; m < 4; ++m) { const float f = ra[ui * BM + ai * HALF + wr * 64 + m * 16 + fr];
#pragma unroll
                for (int bj = 0; bj < 2; ++bj)
#pragma unroll
                    for (int n = 0; n < 2; ++n) acc[ai][bj][m][n] = acc[ai][bj][m][n] * f; }
    }
    __device__ __forceinline__ void operator()(const f32x4 (&acc)[2][2][4][2], const Unit& u, int wr, int wc, int fr, int fq) const {
        const int row0 = u.row0 + wr * 64 + fr, col0 = u.pn * BM + wc * 32 + 8 * fq;
#pragma unroll
        for (int ai = 0; ai < 2; ++ai) {
            u32x4 hv[4][2];
#pragma unroll
            for (int m = 0; m < 4; ++m)
#pragma unroll
                for (int bj = 0; bj < 2; ++bj) hv[m][bj] = *(const u32x4*)(res + (size_t)(row0 + ai * HALF + m * 16) * ldc + col0 + bj * HALF);
            __builtin_amdgcn_sched_barrier(0);
            float s1[4], s2[4];
#pragma unroll
            for (int m = 0; m < 4; ++m) { const size_t off = (size_t)(row0 + ai * HALF + m * 16) * ldc + col0; s1[m] = 0.f; s2[m] = 0.f;
#pragma unroll
                for (int bj = 0; bj < 2; ++bj) { const u32x4 h4 = hv[m][bj]; const f32x4 a0 = acc[ai][bj][m][0], a1 = acc[ai][bj][m][1];
                    u32x4 w;
                    w.x = cvt_pk_bf16(alpha * bf2f(h4.x & 0xffffu) + a0[0], alpha * bf2f(h4.x >> 16) + a0[1]); w.y = cvt_pk_bf16(alpha * bf2f(h4.y & 0xffffu) + a0[2], alpha * bf2f(h4.y >> 16) + a0[3]);
                    w.z = cvt_pk_bf16(alpha * bf2f(h4.z & 0xffffu) + a1[0], alpha * bf2f(h4.z >> 16) + a1[1]); w.w = cvt_pk_bf16(alpha * bf2f(h4.w & 0xffffu) + a1[2], alpha * bf2f(h4.w >> 16) + a1[3]);
                    *(u32x4*)(out + off + bj * HALF) = w;
#pragma unroll
                    for (int q = 0; q < 4; ++q) { const float lo = bf2f(w[q] & 0xffffu), hi = bf2f(w[q] >> 16); s1[m] += lo + hi; s2[m] += lo * lo + hi * hi; } } }
#pragma unroll
            for (int o = 16; o < 64; o <<= 1) {
#pragma unroll
                for (int m = 0; m < 4; ++m) { s1[m] += __shfl_xor(s1[m], o); s2[m] += __shfl_xor(s2[m], o); } }
            if (fq == 0) {
#pragma unroll
                for (int m = 0; m < 4; ++m) { f32x2_e v; v.x = s1[m]; v.y = s2[m]; *(f32x2_e*)(statp + (size_t)(row0 + ai * HALF + m * 16) * 32 + (u.pn * 4 + wc) * 2) = v; } }
        }
    }
};
struct EpiSiluMul {
    static constexpr bool PERM = true;
    bf16_t* O; int ldc;
    __device__ __forceinline__ void operator()(const f32x4 (&acc)[2][2][4][2], const Unit& u, int wr, int wc, int fr, int fq) const {
        const int row0 = u.row0 + wr * 64 + fr, col0 = u.pn * HALF + wc * 32 + 8 * fq;
#pragma unroll
        for (int ai = 0; ai < 2; ++ai)
#pragma unroll
            for (int m = 0; m < 4; ++m) { if (ai == 1 && u.half) continue; bf16_t* rowp = O + (size_t)(row0 + ai * HALF + m * 16) * ldc + col0; float h[8];
#pragma unroll
                for (int n = 0; n < 2; ++n)
#pragma unroll
                    for (int j = 0; j < 4; ++j) { const float g = acc[ai][0][m][n][j], up = acc[ai][1][m][n][j]; h[4 * n + j] = g * __builtin_amdgcn_rcpf(1.f + __builtin_amdgcn_exp2f(-1.4426950408889634f * g)) * up; }
                u32x4 w; w.x = cvt_pk_bf16(h[0], h[1]); w.y = cvt_pk_bf16(h[2], h[3]); w.z = cvt_pk_bf16(h[4], h[5]); w.w = cvt_pk_bf16(h[6], h[7]);
                *(u32x4*)rowp = w; }
    }
};

#ifndef PG8_ALIGN
#define PG8_ALIGN true
#endif
template <class Epi, class Sched, bool GATHER, bool ALIGN_EPI = PG8_ALIGN, bool MIDK = false>
__device__ __forceinline__ void gemm_phase(LAS unsigned char* lds, const int wave_id  , const int K, const int lda, const Sched& S, const Epi& E) {
    int lane_ = lane_id_v();
    const int wid = wave_id, lane = lane_, tid = wid * 64 + lane, wr = wid >> 2, wc = wid & 3, fr = lane & 15, fq = lane >> 4;
    const int nt = K / BK;
    unsigned voffB[2], vA[2][2], nvA[2][2]; int Rr[2], Cb[2];
#pragma unroll
    for (int i = 0; i < 2; ++i) { int R, C; stage_rc(tid * 16 + i * 8192, R, C); const int Rb = Epi::PERM ? ((R & ~31) + perm32(R & 31)) : R;
        voffB[i] = (unsigned)(Rb * K + C) * 2u; Rr[i] = R; Cb[i] = C * 2;
        vA[0][i] = (unsigned)(R * lda + C) * 2u; vA[1][i] = vA[0][i] + (unsigned)(HALF * lda) * 2u; nvA[0][i] = vA[0][i]; nvA[1][i] = vA[1][i]; }
    const size_t kstep = (size_t)(BK * 2);
    const size_t hstepB = (size_t)HALF * K * 2;
    const unsigned ldsw = (unsigned)wid * 1024u;
    const int aoff = lds_byte(wr * 64 + fr, fq * 8), boff = lds_byte(wc * 32 + fr, fq * 8);
#define PG8_SA(b, h) (((b) * 2 + (h)) * HTB)
#define PG8_SB(b, h) ((4 + (b) * 2 + (h)) * HTB)
#define PG8_STAGE2(bufoff, gbase, v0, v1) do { \
        __builtin_amdgcn_global_load_lds((const unsigned*)((const char*)(gbase) + (v0)), (LAS unsigned*)(lds + (bufoff) + ldsw), 16, 0, 0); \
        __builtin_amdgcn_global_load_lds((const unsigned*)((const char*)(gbase) + (v1)), (LAS unsigned*)(lds + (bufoff) + ldsw + 8192), 16, 0, 0); } while (0)
#define PG8_STAGEB(bufoff, gbase) PG8_STAGE2(bufoff, gbase, voffB[0], voffB[1])
#define PG8_LDA(dst, b, h) do { _Pragma("unroll") for (int m = 0; m < 4; ++m) _Pragma("unroll") for (int k = 0; k < 2; ++k) dst[m][k] = *(const LAS bf16x8*)(lds + PG8_SA(b, h) + aoff + m * 2048 + k * 1024); } while (0)
#define PG8_LDB(dst, b, h) do { _Pragma("unroll") for (int n = 0; n < 2; ++n) _Pragma("unroll") for (int k = 0; k < 2; ++k) dst[n][k] = *(const LAS bf16x8*)(lds + PG8_SB(b, h) + boff + n * 2048 + k * 1024); } while (0)
#define PG8_MMA(ai, bj, At, Bt) do { __builtin_amdgcn_s_setprio(1); _Pragma("unroll") for (int m = 0; m < 4; ++m) _Pragma("unroll") for (int n = 0; n < 2; ++n) _Pragma("unroll") for (int k = 0; k < 2; ++k) \
        acc[ai][bj][m][n] = __builtin_amdgcn_mfma_f32_16x16x32_bf16(Bt[n][k], At[m][k], acc[ai][bj][m][n], 0, 0, 0); __builtin_amdgcn_s_setprio(0); } while (0)
#define PG8_WAIT_V(n) asm volatile("s_waitcnt vmcnt(" #n ")" ::: "memory")
#define PG8_WAIT_L(n) asm volatile("s_waitcnt lgkmcnt(" #n ")" ::: "memory")
#define PG8_BAR __builtin_amdgcn_s_barrier()
#define PG8_SCHED __builtin_amdgcn_sched_barrier(0)
#define PG8_GATHER_OFFS(dst, U) do { _Pragma("unroll") for (int h = 0; h < 2; ++h) _Pragma("unroll") for (int i = 0; i < 2; ++i) { const int r_ = h * HALF + Rr[i]; \
        const int tok_ = *(const LAS int*)(lds + (U).rlds + r_ * 4); dst[h][i] = (unsigned)tok_ * (unsigned)(lda * 2) + (unsigned)Cb[i]; } } while (0)
    Unit cur, nxt; int ui = 0;
    if (!S.next(0, cur)) return;
    f32x4 acc[2][2][4][2];
#pragma unroll
    for (int a = 0; a < 2; ++a)
#pragma unroll
        for (int b = 0; b < 2; ++b)
#pragma unroll
            for (int m = 0; m < 4; ++m)
#pragma unroll
                for (int n = 0; n < 2; ++n) acc[a][b][m][n] = (f32x4){0.f, 0.f, 0.f, 0.f};
    bf16x8 At[4][2], B0[2][2], B1[2][2];
    const char* cA = cur.a; const char* cB = cur.b;
    if constexpr (GATHER) { PG8_GATHER_OFFS(vA, cur); }
    PG8_STAGEB(PG8_SB(0, 0), cB); PG8_STAGEB(PG8_SB(0, 1), cB + hstepB); PG8_STAGE2(PG8_SA(0, 0), cA, vA[0][0], vA[0][1]); PG8_STAGE2(PG8_SA(0, 1), cA, vA[1][0], vA[1][1]);
    if (wr == 1) PG8_BAR;
    PG8_WAIT_V(2); PG8_BAR;
    PG8_STAGEB(PG8_SB(1, 0), cB + kstep); PG8_STAGE2(PG8_SA(1, 0), cA + kstep, vA[0][0], vA[0][1]); PG8_STAGEB(PG8_SB(1, 1), cB + hstepB + kstep);
    PG8_WAIT_V(6); PG8_BAR;
    for (;;) {
        const bool has_next = S.next(ui + 1, nxt);
        const char* nA = has_next ? nxt.a : cA; const char* nB = has_next ? nxt.b : cB;
        if constexpr (GATHER) {
            if (has_next) { PG8_GATHER_OFFS(nvA, nxt); }
            else {
#pragma unroll
                for (int h = 0; h < 2; ++h)
#pragma unroll
                    for (int i = 0; i < 2; ++i) nvA[h][i] = vA[h][i]; }
        }
        const bool hf = Sched::HAS_HALF && cur.half != 0;
        for (int t = 0; t < nt; t += 2) {
            const bool last = (t == nt - 2);
            if constexpr (MIDK) { if (t == nt / 2) E.mid(acc, ui, wr, fr); }
            const char* a1 = cA + (size_t)(t + 1) * kstep;
            const char* a2 = last ? nA : cA + (size_t)(t + 2) * kstep; const char* b2 = last ? nB : cB + (size_t)(t + 2) * kstep;
            const char* a3 = a2 + kstep; const char* b3 = b2 + kstep;
            unsigned x00 = vA[0][0], x01 = vA[0][1], x10 = vA[1][0], x11 = vA[1][1];
            if constexpr (GATHER) { if (last) { x00 = nvA[0][0]; x01 = nvA[0][1]; x10 = nvA[1][0]; x11 = nvA[1][1]; } }
            PG8_LDB(B0, 0, 0); PG8_LDB(B1, 0, 1); PG8_SCHED; PG8_LDA(At, 0, 0); PG8_STAGE2(PG8_SA(1, 1), a1, vA[1][0], vA[1][1]);
            PG8_WAIT_V(8); PG8_WAIT_L(0); PG8_BAR; PG8_MMA(0, 0, At, B0); PG8_MMA(0, 1, At, B1); PG8_BAR; PG8_SCHED;
            if (!hf) PG8_LDA(At, 0, 1); PG8_STAGEB(PG8_SB(0, 0), b2); PG8_STAGEB(PG8_SB(0, 1), b2 + hstepB); PG8_STAGE2(PG8_SA(0, 0), a2, x00, x01);
            PG8_WAIT_V(8); PG8_WAIT_L(0); PG8_BAR; if (!hf) { PG8_MMA(1, 0, At, B0); PG8_MMA(1, 1, At, B1); } PG8_BAR; PG8_SCHED;
            PG8_LDB(B0, 1, 0); PG8_LDB(B1, 1, 1); PG8_SCHED; PG8_LDA(At, 1, 0); PG8_STAGE2(PG8_SA(0, 1), a2, x10, x11);
            PG8_WAIT_V(8); PG8_WAIT_L(0); PG8_BAR; PG8_MMA(0, 0, At, B0); PG8_MMA(0, 1, At, B1); PG8_BAR; PG8_SCHED;
            if (!hf) PG8_LDA(At, 1, 1); PG8_STAGEB(PG8_SB(1, 0), b3); PG8_STAGEB(PG8_SB(1, 1), b3 + hstepB); PG8_STAGE2(PG8_SA(1, 0), a3, x00, x01);
            PG8_WAIT_V(8); PG8_WAIT_L(0); PG8_BAR; if (!hf) { PG8_MMA(1, 0, At, B0); PG8_MMA(1, 1, At, B1); } PG8_BAR; PG8_SCHED;
        }
        if (ALIGN_EPI) { if (wr == 0) PG8_BAR; }
        E(acc, cur, wr, wc, fr, fq);
        if (!has_next) break;
#pragma unroll
        for (int a = 0; a < 2; ++a)
#pragma unroll
            for (int b = 0; b < 2; ++b)
#pragma unroll
                for (int m = 0; m < 4; ++m)
#pragma unroll
                    for (int n = 0; n < 2; ++n) acc[a][b][m][n] = (f32x4){0.f, 0.f, 0.f, 0.f};
        cur = nxt; cA = nA; cB = nB; ++ui;
#pragma unroll
        for (int h = 0; h < 2; ++h)
#pragma unroll
            for (int i = 0; i < 2; ++i) vA[h][i] = nvA[h][i];
        if (ALIGN_EPI) { if (wr == 1) PG8_BAR; }
    }
    PG8_WAIT_V(0);
    if (!ALIGN_EPI) { if (wr == 0) PG8_BAR; }
    PG8_BAR;
#undef PG8_SA
#undef PG8_SB
#undef PG8_STAGE2
#undef PG8_STAGEB
#undef PG8_LDA
#undef PG8_LDB
#undef PG8_MMA
#undef PG8_WAIT_V
#undef PG8_WAIT_L
#undef PG8_BAR
#undef PG8_SCHED
#undef PG8_GATHER_OFFS
}
}

namespace sb {
typedef float f32x16 __attribute__((ext_vector_type(16)));
typedef short s16x4 __attribute__((ext_vector_type(4)));
typedef float f32x2_t __attribute__((ext_vector_type(2)));
typedef __bf16 bf16x2_t __attribute__((ext_vector_type(2)));
constexpr int VPITCH = 128;
constexpr int VTILE_BYTES = 2 * 64 * VPITCH;
constexpr float EXIT2 = -66.0f;
__device__ __forceinline__ int crow(int r, int h) { return (r & 3) + 8 * (r >> 2) + 4 * h; }
__device__ __forceinline__ int krow(int s, int h, int j) { return 16 * s + 8 * (j >> 2) + 4 * h + (j & 3); }
__device__ __forceinline__ unsigned cvtpk(float lo, float hi) { f32x2_t v = {lo, hi}; bf16x2_t b = __builtin_convertvector(v, bf16x2_t); return __builtin_bit_cast(unsigned, b); }
#define SB_MFMA(a, b, c) __builtin_amdgcn_mfma_f32_32x32x16_bf16((a), (b), (c), 0, 0, 0)
template <int S> __device__ __forceinline__ bf16x8 pack8(const f32x16& x) {
    u32x4 p; p.x = cvtpk(x[8 * S + 0], x[8 * S + 1]); p.y = cvtpk(x[8 * S + 2], x[8 * S + 3]); p.z = cvtpk(x[8 * S + 4], x[8 * S + 5]); p.w = cvtpk(x[8 * S + 6], x[8 * S + 7]);
    return __builtin_bit_cast(bf16x8, p);
}
template <int S> __device__ __forceinline__ void pack8_hilo(const f32x16& x, bf16x8& hi, bf16x8& lo) {
    u32x4 ph, pl;
#pragma unroll
    for (int w = 0; w < 4; ++w) {
        const float a = x[8 * S + 2 * w], b = x[8 * S + 2 * w + 1];
        const unsigned h = cvtpk(a, b);
        const float ah = __builtin_bit_cast(float, h << 16), bh = __builtin_bit_cast(float, h & 0xffff0000u);
        ph[w] = h; pl[w] = cvtpk(a - ah, b - bh);
    }
    hi = __builtin_bit_cast(bf16x8, ph); lo = __builtin_bit_cast(bf16x8, pl);
}
__device__ __forceinline__ s16x4 vtr(LAS const unsigned char* p) { typedef short v4i16_t __attribute__((ext_vector_type(4))); return __builtin_bit_cast(s16x4, __builtin_amdgcn_ds_read_tr16_b64_v4i16((LAS v4i16_t*)p)); }

__device__ __forceinline__ float log2keep(float x) {
    const float t = __builtin_amdgcn_exp2f(-__builtin_fabsf(x));
    return __builtin_fmaf(-0.5f, x + __builtin_fabsf(x), -__builtin_amdgcn_logf(1.f + t));
}

__device__ __forceinline__ void glds16(const void* gsrc, unsigned lds_dst) { unsigned keep;
  asm volatile("s_mov_b32 %0, m0\n\ts_mov_b32 m0, %2\n\ts_nop 0\n\tglobal_load_lds_dwordx4 %1, off\n\ts_mov_b32 m0, %0" : "=&s"(keep) : "v"(gsrc), "s"(lds_dst) : "memory"); }
struct AttnPre { bf16x8 qf[4], nk0[4], nk1[4]; };
#define SB_LOAD_TILE_TO(NK0, NK1, TOK0, KV0, BUF) do { int lv_ = lane; asm volatile("" : "+v"(lv_)); \
        const bf16_t* kp_ = proj + (size_t)((TOK0) + (KV0) + (lv_ & 31)) * PP + PO_K + h * HD + 8 * (lv_ >> 5); \
        _Pragma("unroll") for (int s = 0; s < 4; ++s) { NK0[s] = *(const bf16x8*)(kp_ + 16 * s); NK1[s] = *(const bf16x8*)(kp_ + (size_t)32 * PP + 16 * s); } \
        const bf16_t* vp_ = proj + (size_t)((TOK0) + (KV0) + (lv_ >> 3)) * PP + PO_V + h * HD + 8 * (lv_ & 7); \
        const unsigned vd_ = (unsigned)(size_t)(vlds) + (BUF) * 8192; \
        _Pragma("unroll") for (int it = 0; it < 8; ++it) glds16(vp_ + (size_t)it * 8 * PP, vd_ + it * 1024); } while (0)
__device__ __forceinline__ void attn_issue(AttnPre& P, const bf16_t* proj, int b, int q0, int h, int lane, LAS unsigned char* vlds, int vbuf = 0) {
    const int tok0 = b * SEQ;
    { int lq = lane; asm volatile("" : "+v"(lq));
      const bf16_t* qp = proj + (size_t)(tok0 + q0 + (lq & 31)) * PP + PO_Q + h * HD + 8 * (lq >> 5);
#pragma unroll
      for (int s = 0; s < 4; ++s) P.qf[s] = *(const bf16x8*)(qp + 16 * s); }
    SB_LOAD_TILE_TO(P.nk0, P.nk1, tok0, (q0 >> 6) * 64, vbuf);
}
__device__ __forceinline__ void attn_wave(AttnPre& P, const bf16_t* proj, int b, int q0, int h, int lane, LAS unsigned char* vlds, f32x16& o0, f32x16& o1, int ntq  , int& vbuf  ) {
    const int r = lane & 31, hh = lane >> 5;
    const int tok0 = b * SEQ;
    bf16x8 qf[4];
#pragma unroll
    for (int s = 0; s < 4; ++s) qf[s] = P.qf[s];
    bf16x8 triA[2], onesA;
#pragma unroll
    for (int j = 0; j < 8; ++j) { onesA[j] = (short)0x3F80; triA[0][j] = (krow(0, hh, j) >= r) ? (short)0x3F80 : (short)0; triA[1][j] = (krow(1, hh, j) >= r) ? (short)0x3F80 : (short)0; }
#pragma unroll
    for (int i = 0; i < 16; ++i) { o0[i] = 0.f; o1[i] = 0.f; }
    float carry = 0.f;
    const int jt0 = q0 >> 6;
    bf16x8 nk0[4], nk1[4];
#pragma unroll
    for (int s = 0; s < 4; ++s) { nk0[s] = P.nk0[s]; nk1[s] = P.nk1[s]; }
#define SB_LOAD_TILE(KV0, BUF) SB_LOAD_TILE_TO(nk0, nk1, tok0, KV0, BUF)
    int buf = vbuf;
    for (int jt = jt0; jt >= 0; --jt) {
        const int kv0 = jt * 64;
        int lv = lane; asm volatile("" : "+v"(lv));
        asm volatile("s_waitcnt vmcnt(0)" ::: "memory");
        bf16x8 k0[4], k1[4];
#pragma unroll
        for (int s = 0; s < 4; ++s) { k0[s] = nk0[s]; k1[s] = nk1[s]; }
        LAS const unsigned char* vrd = vlds + buf * 8192 + (4 * (lv >> 5) + ((lv & 15) >> 2)) * VPITCH + (16 * ((lv >> 4) & 1) + 4 * (lv & 3)) * 2;
        buf ^= 1;
        f32x16 p0, p1;
#pragma unroll
        for (int i = 0; i < 16; ++i) { p0[i] = 0.f; p1[i] = 0.f; }
#pragma unroll
        for (int s = 0; s < 4; ++s) p0 = SB_MFMA(k0[s], qf[s], p0);
#pragma unroll
        for (int s = 0; s < 4; ++s) p1 = SB_MFMA(k1[s], qf[s], p1);
        const bool diag = (jt == jt0);
        const int dq = q0 + (lv & 31) - kv0 - 4 * (lv >> 5);
        bf16x8 x0[2], x1[2];
        { f32x16 L0, L1;
#pragma unroll
          for (int i = 0; i < 16; ++i) {
              float a = log2keep(p0[i]), c = log2keep(p1[i]);
              if (diag) { const int ci = (i & 3) + 8 * (i >> 2); if (!(ci < dq)) a = 0.f; if (!(ci + 32 < dq)) c = 0.f; }
              L0[i] = a; L1[i] = c;
          }
          x0[0] = pack8<0>(L0); x0[1] = pack8<1>(L0); x1[0] = pack8<0>(L1); x1[1] = pack8<1>(L1); }
        f32x16 T1, TT;
        { f32x16 Y1;
#pragma unroll
          for (int i = 0; i < 16; ++i) { T1[i] = 0.f; Y1[i] = 0.f; }
#pragma unroll
          for (int s = 0; s < 2; ++s) { T1 = SB_MFMA(onesA, x1[s], T1); Y1 = SB_MFMA(triA[s], x1[s], Y1); }
#pragma unroll
          for (int i = 0; i < 16; ++i) p1[i] += Y1[i]; }
        { f32x16 Y0 = T1; TT = T1;
#pragma unroll
          for (int s = 0; s < 2; ++s) { Y0 = SB_MFMA(triA[s], x0[s], Y0); TT = SB_MFMA(onesA, x0[s], TT); }
#pragma unroll
          for (int i = 0; i < 16; ++i) p0[i] += Y0[i]; }
        const float ncarry = carry + TT[0];
        const bool last = (jt == 0) || __all(ncarry < EXIT2);
        if (!last) SB_LOAD_TILE(kv0 - 64, buf);
        else if (ntq >= 0) { attn_issue(P, proj, ntq / SEQ, ntq % SEQ, h, lane, vlds, buf); vbuf = buf; }
#pragma unroll
        for (int i = 0; i < 16; ++i) {
            float a = __builtin_amdgcn_exp2f(p0[i] + carry), c = __builtin_amdgcn_exp2f(p1[i] + carry);
            if (diag) { const int ci = (i & 3) + 8 * (i >> 2); if (!(ci < dq)) a = 0.f; if (!(ci + 32 < dq)) c = 0.f; }
            p0[i] = a; p1[i] = c;
        }
#define SB_VB(c, s, db) __builtin_shufflevector(vtr(vrd + (32 * (c) + 16 * (s)) * VPITCH + 64 * (db)), vtr(vrd + (32 * (c) + 16 * (s) + 8) * VPITCH + 64 * (db)), 0, 1, 2, 3, 4, 5, 6, 7)
        { const bf16x8 pa = pack8<0>(p0); o0 = SB_MFMA(pa, SB_VB(0, 0, 0), o0); o1 = SB_MFMA(pa, SB_VB(0, 0, 1), o1); }
        { const bf16x8 pa = pack8<1>(p0); o0 = SB_MFMA(pa, SB_VB(0, 1, 0), o0); o1 = SB_MFMA(pa, SB_VB(0, 1, 1), o1); }
        { const bf16x8 pa = pack8<0>(p1); o0 = SB_MFMA(pa, SB_VB(1, 0, 0), o0); o1 = SB_MFMA(pa, SB_VB(1, 0, 1), o1); }
        { const bf16x8 pa = pack8<1>(p1); o0 = SB_MFMA(pa, SB_VB(1, 1, 0), o0); o1 = SB_MFMA(pa, SB_VB(1, 1, 1), o1); }
#undef SB_VB
        carry = ncarry;
        if (last) break;
    }
}
#undef SB_MFMA
#undef SB_LOAD_TILE
#undef SB_LOAD_TILE_TO
}

constexpr int I_IN = (D / 64) * (NPROJ / 32), I_OUT = (D / 64) * (D / 32), I_EXP = NE * 256, I_LAYER = I_IN + I_OUT + 3 * I_EXP;
struct CvtItem { const float* src; bf16_t* dst; int ldw, ldt; float scale; };
__device__ __forceinline__ CvtItem cvt_decode(const Ptrs& p, int it, int lane) {
    const int l = it / I_LAYER; int r = it - l * I_LAYER;
    const float* W; bf16_t* WT; int ldw, ldt, k0, n0, drow0, kdst = -1; float scale = 1.f;
    if (r < I_IN) { const int kb = r / (NPROJ / 32), nb = r % (NPROJ / 32), blk = (32 * nb) >> 9, c = (32 * nb) & 511; n0 = 32 * nb; k0 = 64 * kb;
        drow0 = (blk == 0) ? c : (blk == 1) ? 1024 + (c >> 7) * 256 + (c & 127) : (blk == 2) ? 1024 + (c >> 7) * 256 + 128 + (c & 127) : (blk == 3) ? 512 + c : (blk == 4) ? 2048 + c : 2560 + c;
        W = p.w_in + (size_t)l * D * NPROJ; ldw = NPROJ; WT = (bf16_t*)(p.ws + WS_WIN) + (size_t)l * NPROJ * D; ldt = D; scale = blk == 3 ? QSCALE : 1.f; }
    else if (r < I_IN + I_OUT) { r -= I_IN; const int kb = r / (D / 32), nb = r % (D / 32); n0 = 32 * nb; k0 = 64 * kb;
        W = p.w_out + (size_t)l * D * D; ldw = D; WT = (bf16_t*)(p.ws + WS_WOUT) + (size_t)l * D * D; ldt = D; drow0 = n0; kdst = (k0 + 512) & 1023; }
    else { r -= I_IN + I_OUT; const int which = r / I_EXP; r -= which * I_EXP; const int e = r >> 8; r &= 255;
        if (which < 2) { const int kb = r >> 4, nb = r & 15; n0 = 32 * nb; k0 = 64 * kb;
            W = (which ? p.w_up : p.w_gate) + ((size_t)l * NE + e) * D * DEXP; ldw = DEXP; WT = (bf16_t*)(p.ws + WS_WGU) + ((size_t)l * NE + e) * 1024 * 1024; ldt = 1024; drow0 = (n0 >> 7) * 256 + (n0 & 127) + which * 128; }
        else { const int kb = r >> 5, nb = r & 31; n0 = 32 * nb; k0 = 64 * kb;
            W = p.w_down + ((size_t)l * NE + e) * DEXP * D; ldw = D; WT = (bf16_t*)(p.ws + WS_WD) + ((size_t)l * NE + e) * 1024 * 512; ldt = 512; drow0 = n0; } }
    CvtItem c; c.src = W + (size_t)(k0 + (lane >> 5)) * ldw + n0 + (lane & 31); c.dst = WT + (size_t)(drow0 + (lane >> 3)) * ldt + (kdst >= 0 ? kdst : k0) + 8 * (lane & 7); c.ldw = ldw; c.ldt = ldt; c.scale = scale; return c;
}
__device__ __forceinline__ void cvt_load(const CvtItem& c, float (&t)[32]) {
#pragma unroll
    for (int i = 0; i < 32; ++i) t[i] = c.src[(size_t)(2 * i) * c.ldw];
}
__device__ __forceinline__ void cvt_store(const CvtItem& c, const float (&t)[32], LAS float* scr, int lane) {
#pragma unroll
    for (int i = 0; i < 32; ++i) scr[(2 * i + (lane >> 5)) * 33 + (lane & 31)] = t[i];
    LDS_WAIT(); asm volatile("" ::: "memory");
    const int cc = lane & 7; const float scale = c.scale;
#pragma unroll
    for (int j = 0; j < 4; ++j) { const int n = (lane >> 3) + 8 * j; const LAS float* s = scr + (8 * cc) * 33 + n;
        u32x4 o; o.x = pk2(s[0 * 33] * scale, s[1 * 33] * scale); o.y = pk2(s[2 * 33] * scale, s[3 * 33] * scale); o.z = pk2(s[4 * 33] * scale, s[5 * 33] * scale); o.w = pk2(s[6 * 33] * scale, s[7 * 33] * scale);
        *(u32x4*)(c.dst + (size_t)(8 * j) * c.ldt) = o; }
    LDS_WAIT(); asm volatile("" ::: "memory");
}
__device__ __forceinline__ void cvt_run(const Ptrs& p, int it0, int it1, int step, LAS float* scr, int lane) {
    if (it0 >= it1) return;
    float ta[32], tb[32];
    CvtItem ca = cvt_decode(p, it0, lane), cb = ca;
    cvt_load(ca, ta);
    for (int it = it0; it < it1; it += 2 * step) {
        const bool hb = it + step < it1;
        if (hb) { cb = cvt_decode(p, it + step, lane); cvt_load(cb, tb); }
        cvt_store(ca, ta, scr, lane);
        if (!hb) break;
        const bool ha = it + 2 * step < it1;
        if (ha) { ca = cvt_decode(p, it + 2 * step, lane); cvt_load(ca, ta); }
        cvt_store(cb, tb, scr, lane);
    }
}
__device__ __forceinline__ void ln_finish_row(f32x4 (&v)[4], const float* g, const float* b, bf16_t* ob, float* of, int lane) {
    float s = 0.f;
#pragma unroll
    for (int j = 0; j < 4; ++j) s += (v[j].x + v[j].y) + (v[j].z + v[j].w);
    const float mean = wave_sum(s) * (1.f / D); float s2 = 0.f;
#pragma unroll
    for (int j = 0; j < 4; ++j) { v[j] = v[j] - mean; s2 += (v[j].x * v[j].x + v[j].y * v[j].y) + (v[j].z * v[j].z + v[j].w * v[j].w); }
    const float rstd = 1.f / sqrtf(wave_sum(s2) * (1.f / D) + LN_EPS);
#pragma unroll
    for (int j = 0; j < 4; ++j) {
        const int c = 4 * (64 * j + lane);
        v[j] = v[j] * rstd * *(const f32x4*)(g + c) + *(const f32x4*)(b + c);
        if (ob) { u32x2 w; w.x = pk2(v[j].x, v[j].y); w.y = pk2(v[j].z, v[j].w); *(u32x2*)(ob + c) = w; }
        if (of) *(f32x4*)(of + c) = v[j];
    }
}

struct MoeSched {
    static constexpr bool HAS_HALF = true;
    const LAS int* tabS; const LAS int* tabE; const LAS int* tabC; int G, vcu, npn; bool down;
    const char* A; const char* W; const int* list;
    __device__ __forceinline__ bool next(int i, pg8::Unit& u) const {
        const int total = __builtin_amdgcn_readfirstlane(tabS[NE]) * npn, nfr = total / G, R = total - nfr * G;
        int L, half = 0, second = 0;
        if (i < nfr) L = i * G + vcu;
        else if (i == nfr && vcu < 2 * R) { L = nfr * G + (vcu >> 1); half = 1; second = vcu & 1; }
        else return false;
        const int rb = L / npn, pn = L % npn;
        const int e = __builtin_amdgcn_readfirstlane(tabE[rb]), lb = rb - __builtin_amdgcn_readfirstlane(tabS[e]), cnt = __builtin_amdgcn_readfirstlane(tabC[e]);
        int nv = cnt - lb * 256 - 128 * second; nv = nv < 0 ? 0 : nv; const int cap = half ? 128 : 256;
        if (nv == 0) return false;
        u.pm = rb; u.pn = pn; u.row0 = rb * 256 + 128 * second; u.half = half; u.nvalid = nv < cap ? nv : cap; u.rl = list + (size_t)e * T + lb * 256 + 128 * second; u.rlds = TOKT_OFF + i * 1024;
        if (!down) { u.a = A; u.b = W + (size_t)e * (1024 * 1024 * 2) + (size_t)pn * (256 * 1024 * 2); }
        else { u.a = A + (size_t)(rb * 256 + 128 * second) * (DEXP * 2); u.b = W + (size_t)e * (1024 * 512 * 2) + (size_t)pn * (256 * 512 * 2); }
        return true;
    }
};


constexpr int XS_OFF = LDSCTL_OFF + 2048;
constexpr int RA_OFF = LDSCTL_OFF + 4096;
constexpr int GB_OFF = LDSCTL_OFF + 8192;
constexpr int LG16_OFF = LDSCTL_OFF + 16384;
constexpr int RT_OFF = LDSCTL_OFF + 4096;

__device__ __forceinline__ int fresh_lane() { return lane_id_v(); }
struct Args { Ptrs p; int ph_lo, ph_hi, li, pad; };

__device__ __forceinline__ void moe_tables(unsigned* ctl, int l, int wave_id, LAS int* tabS, LAS int* tabC, LAS int* tabE) {
    __syncthreads();
    const int tid = wave_id * 64 + fresh_lane();
    if (tid < 64) {
        const int e = tid & 31; const int c = (int)__hip_atomic_load(ctl + CW_CNT + 64 * l + e, RLX_AGENT); const int nb = (c + 255) >> 8;
        int incl = nb;
#pragma unroll
        for (int o = 1; o < 32; o <<= 1) { const int t = __shfl_up(incl, o, 32); if (e >= o) incl += t; }
        if (tid < 32) { tabS[e] = incl - nb; tabC[e] = c; if (e == 31) tabS[32] = incl; for (int rb = incl - nb; rb < incl; ++rb) tabE[rb] = e; }
    }
    __syncthreads();
}

__global__ void __launch_bounds__(NWAVES * 64, 2) mk_fwd(Args args) {
    extern __shared__ __attribute__((aligned(16))) unsigned char lds_raw[];
    LAS unsigned char* lds = (LAS unsigned char*)lds_raw;
    const Ptrs& p = args.p;
    const int tid0 = threadIdx.x; const int wave_s = __builtin_amdgcn_readfirstlane(tid0 >> 6);
    constexpr int G = 256;
    const int bx = blockIdx.x, vcu = (bx % 8) * (G / 8) + bx / 8;
    unsigned* ctl = (unsigned*)(p.ws + WS_CTL);
    for (int u = tid0; u < (LDS_BYTES - LDSCTL_OFF) / 4; u += NWAVES * 64) ((LAS unsigned*)(lds + LDSCTL_OFF))[u] = 0u;
    __syncthreads();
    volatile LAS unsigned* MISC = (volatile LAS unsigned*)(lds + MISC_OFF);
    XcdBarrier bar = xcd_barrier_post(ctl + CW_BAR + args.li * XCD_BAR_WORDS, MISC);
    LAS int* tabS = (LAS int*)(lds + TAB_OFF); LAS int* tabC = tabS + 40; LAS int* tabE = tabS + 80;
    constexpr int NGW = G * NWAVES;
    int tab_layer = -1;
    bf16_t* const PROJ = (bf16_t*)(p.ws + WS_PROJ);

    for (int ph = args.ph_lo; ph < args.ph_hi; ++ph) {
      const int nrep = 1 + ((PROBE_MASK >> (ph == 0 ? 0 : 1 + (ph - 1) % 7)) & 1);
      for (int rep = 0; rep < nrep; ++rep) {
        if (ph > args.ph_lo || rep > 0) xcd_barrier(bar, wave_s);
        int lane_ = lane_id_v();
        const int lane = lane_, wave = wave_s, gw = vcu * NWAVES + wave;
#define tid (wave * 64 + fresh_lane())
        if (ph == 0) {
            LAS float* scr = (LAS float*)(lds + wave * 16384);
            if (vcu < 64) { const int idx = vcu * 512 + tid, k = idx >> 5, e = idx & 31; const float w = p.router_w[idx]; const unsigned hi = f2bf(w), lo = f2bf(w - bf2f(hi));
                const int off = e * D + ((((k >> 3) ^ (e & 15))) << 3) + (k & 7); unsigned short* im = (unsigned short*)(p.ws + WS_WRT); im[off] = (unsigned short)hi; im[NE * D + off] = (unsigned short)lo; }
            { int g0_ = gw; asm volatile("" : "+s"(g0_)); cvt_run(p, g0_, I_IN, NGW, scr, lane); }
            { f32x4 nv[4], gg[4], bb[4];
#pragma unroll
              for (int j = 0; j < 4; ++j) { gg[j] = *(const f32x4*)(p.ln0_g + 4 * (64 * j + lane)); bb[j] = *(const f32x4*)(p.ln0_b + 4 * (64 * j + lane)); }
              { const f32x4* xr = (const f32x4*)(p.x + (size_t)gw * D) + lane;
#pragma unroll
                for (int j = 0; j < 4; ++j) nv[j] = xr[64 * j]; }
              for (int m = gw; m < T; m += NGW) {
                f32x4 v[4];
#pragma unroll
                for (int j = 0; j < 4; ++j) v[j] = nv[j];
                if (m + NGW < T) { const f32x4* xr = (const f32x4*)(p.x + (size_t)(m + NGW) * D) + lane;
#pragma unroll
                    for (int j = 0; j < 4; ++j) nv[j] = xr[64 * j]; }
                float s1 = 0.f, s2 = 0.f;
#pragma unroll
                for (int j = 0; j < 4; ++j) { s1 += (v[j].x + v[j].y) + (v[j].z + v[j].w); s2 += (v[j].x * v[j].x + v[j].y * v[j].y) + (v[j].z * v[j].z + v[j].w * v[j].w); }
                s1 = wave_sum(s1); s2 = wave_sum(s2);
                const float mean = s1 * (1.f / D), rstd = 1.f / sqrtf(fmaxf(s2 * (1.f / D) - mean * mean, 0.f) + LN_EPS);
                bf16_t* hb = (bf16_t*)(p.ws + WS_HB) + (size_t)m * D;
#pragma unroll
                for (int j = 0; j < 4; ++j) {
                    const int c = 4 * (64 * j + lane);
                    const f32x4 o = (v[j] - mean) * rstd * gg[j] + bb[j];
                    u32x2 w; w.x = pk2(o.x, o.y); w.y = pk2(o.z, o.w); *(u32x2*)(hb + c) = w;
                }
              } }
            continue;
        }
        const int l = (ph - 1) / 7, sub = (ph - 1) % 7;
        if (sub == 0) {
            pg8::StaticOrder S; S.init(p.ws + WS_HB, D, (bf16_t*)(p.ws + WS_WIN) + (size_t)l * NPROJ * D, T, NPROJ, D, G, bx);
            pg8::EpiInProj E{PROJ, PP};
            const int gsplit = (l == 0) ? (vcu % 7) : 0;
            for (int part = 0; part < 2; ++part) {
                S.r0 = part ? gsplit : 0; S.r1 = part ? (1 << 30) : gsplit;
                if (S.r0 < S.r1) pg8::gemm_phase<pg8::EpiInProj, pg8::StaticOrder, false>(lds, wave, D, D, S, E);
                if (part == 0 && l == 0 && !(nrep == 2 && rep == 1)) {
                    LAS float* scr = (LAS float*)(lds + wave * 16384);
                    { constexpr int CH = (DEPTH * I_LAYER - I_IN + G - 1) / G;
                      int g0_ = I_IN + vcu * CH + wave; asm volatile("" : "+s"(g0_)); const int e_ = I_IN + (vcu + 1) * CH; cvt_run(p, g0_, e_ < DEPTH * I_LAYER ? e_ : DEPTH * I_LAYER, NWAVES, scr, fresh_lane()); }
                    LDS_WAIT(); __syncthreads();
                }
            }
        } else if (sub == 1) {
            const int h = wave;
            const bool dry = (nrep == 2 && rep == 0);
            const bool do_attn = !dry, do_conv = !dry || (PROBE_MASK & 0x200);
            sb::AttnPre pre;
#pragma unroll
            for (int s = 0; s < 4; ++s) { pre.qf[s] = (bf16x8){0, 0, 0, 0, 0, 0, 0, 0}; pre.nk0[s] = pre.qf[s]; pre.nk1[s] = pre.qf[s]; }
            int vbuf0 = 0;
            { const int r_ = lane & 31;
              pg8::f32x2_e gq_; gq_.x = p.g_attn[l * DA + h * HD + r_]; gq_.y = p.g_attn[l * DA + h * HD + 32 + r_]; *(LAS pg8::f32x2_e*)(lds + LDSCTL_OFF + 8192 + wave * 1024 + 8 * lane) = gq_; }
            if (do_attn && vcu < NBATCH * (SEQ / 32)) sb::attn_issue(pre, PROJ, vcu / (SEQ / 32), (vcu % (SEQ / 32)) * 32, h, lane, lds + wave * sb::VTILE_BYTES);
            for (int i = 0; do_attn; ++i) {
                const int u = i * G + vcu; if (u >= NBATCH * (SEQ / 32)) break;
                const int b = u / (SEQ / 32), q0 = (u % (SEQ / 32)) * 32;
                sb::f32x16 o0, o1;
                { const int un_ = u + G; const bool hn_ = un_ < NBATCH * (SEQ / 32);
                  sb::attn_wave(pre, PROJ, b, q0, h, lane, lds + wave * sb::VTILE_BYTES, o0, o1, hn_ ? un_ * 32 : -1, vbuf0); }
                int le = lane; asm volatile("" : "+v"(le));
                const int r = le & 31, hh = le >> 5;
                { float ss[16], a8[8], a4[4], a2[2], a1;
#pragma unroll
                  for (int k = 0; k < 16; ++k) ss[k] = o0[k] * o0[k] + o1[k] * o1[k];
                  { const bool up = (r & 16) != 0;
#pragma unroll
                    for (int k = 0; k < 8; ++k) { const float mine = up ? ss[k + 8] : ss[k], oth = up ? ss[k] : ss[k + 8]; a8[k] = mine + __shfl_xor(oth, 16); } }
                  { const bool up = (r & 8) != 0;
#pragma unroll
                    for (int k = 0; k < 4; ++k) { const float mine = up ? a8[k + 4] : a8[k], oth = up ? a8[k] : a8[k + 4]; a4[k] = mine + __shfl_xor(oth, 8); } }
                  { const bool up = (r & 4) != 0;
#pragma unroll
                    for (int k = 0; k < 2; ++k) { const float mine = up ? a4[k + 2] : a4[k], oth = up ? a4[k] : a4[k + 2]; a2[k] = mine + __shfl_xor(oth, 4); } }
                  { const bool up = (r & 2) != 0; const float mine = up ? a2[1] : a2[0], oth = up ? a2[0] : a2[1]; a1 = mine + __shfl_xor(oth, 2); }
                  a1 += __shfl_xor(a1, 1);
                  const int k = r >> 1;
                  if ((r & 1) == 0) ((float*)(p.ws + WS_SSQ))[(size_t)(b * SEQ + q0 + sb::crow(k, hh)) * 8 + h] = a1; }
                const pg8::f32x2_e gq_ = *(LAS const pg8::f32x2_e*)(lds + LDSCTL_OFF + 8192 + wave * 1024 + 8 * le); const float g0 = gq_.x, g1 = gq_.y;
                bf16_t* op = PROJ + (size_t)(b * SEQ + q0 + 4 * hh) * PP + PO_Q + h * HD + r;
#pragma unroll
                for (int k = 0; k < 16; ++k) {
                    op[(size_t)((k & 3) + 8 * (k >> 2)) * PP] = (bf16_t)f2bf(o0[k] * g0);
                    op[(size_t)((k & 3) + 8 * (k >> 2)) * PP + 32] = (bf16_t)f2bf(o1[k] * g1);
                }
            }
            if (do_conv) {
                const int RPW = T / NGW, m0 = gw * RPW, tpos0 = m0 % SEQ;
                const float* cwp = p.conv_w + (size_t)l * 3 * DC + 8 * lane; const float* gp = p.g_conv + l * DC + 8 * lane;
                float w0c[8], w1c[8], w2c[8], gc[8];
#pragma unroll
                for (int j = 0; j < 8; ++j) { w0c[j] = cwp[j]; w1c[j] = cwp[DC + j]; w2c[j] = cwp[2 * DC + j]; gc[j] = gp[j]; }
                float u1[8], u2[8];
                { const bf16_t* pr = PROJ + (size_t)m0 * PP + 8 * lane; const u32x4 z4 = (u32x4){0u, 0u, 0u, 0u};
                  unpack8(tpos0 >= 1 ? *(const u32x4*)(pr - PP + PO_U) : z4, u1); unpack8(tpos0 >= 2 ? *(const u32x4*)(pr - 2 * PP + PO_U) : z4, u2); }
                u32x4 nq[4][2];
#pragma unroll
                for (int d = 0; d < 4; ++d) { const bf16_t* pr = PROJ + (size_t)(m0 + (d < RPW ? d : 0)) * PP + 8 * lane; nq[d][0] = *(const u32x4*)(pr + PO_B); nq[d][1] = *(const u32x4*)(pr + PO_U); }
                static_assert(RPW % 4 == 0, "conv ring");
#define CONV_ROW(d) { const int mm = m0 + i + d; bf16_t* pr = PROJ + (size_t)mm * PP + 8 * lane; float cb[8], u0[8]; asm volatile("" : "+v"(nq[d][0]), "+v"(nq[d][1]) :: "memory");     \
                    unpack8(nq[d][0], cb); unpack8(nq[d][1], u0); \
                    if (i + d + 4 < RPW) { const bf16_t* pn_ = pr + 4 * PP; nq[d][0] = *(const u32x4*)(pn_ + PO_B); nq[d][1] = *(const u32x4*)(pn_ + PO_U); }     \
                    float co[8], ss = 0.f; \
                    _Pragma("unroll") for (int j = 0; j < 8; ++j) { co[j] = cb[j] * (w0c[j] * u2[j] + w1c[j] * u1[j] + w2c[j] * u0[j]); ss += co[j] * co[j]; u2[j] = u1[j]; u1[j] = u0[j]; } \
                    const float rr = 1.f / sqrtf(wave_sum(ss) * (1.f / DC) + RMS_EPS); \
                    u32x4 w; w.x = pk2(co[0] * rr * gc[0], co[1] * rr * gc[1]); w.y = pk2(co[2] * rr * gc[2], co[3] * rr * gc[3]); w.z = pk2(co[4] * rr * gc[4], co[5] * rr * gc[5]); w.w = pk2(co[6] * rr * gc[6], co[7] * rr * gc[7]); \
                    if (dry) *(u32x4*)((bf16_t*)(p.ws + WS_H1B) + (size_t)mm * D + 512 + 8 * lane) = w; else *(u32x4*)(pr + PO_B) = w; }
#pragma unroll
                for (int i = 0; i < RPW; i += 4) { CONV_ROW(0) CONV_ROW(1) CONV_ROW(2) CONV_ROW(3) }
#undef CONV_ROW
            }
        } else if (sub == 2) {
            pg8::StaticOrder S; S.init(p.ws + WS_PROJ, PP, (bf16_t*)(p.ws + WS_WOUT) + (size_t)l * D * D, T, D, D, G, bx);
            LAS float* ra = (LAS float*)(lds + RA_OFF);
            { const int t_ = tid, uo = t_ >> 8; pg8::Unit uu{};
              if (S.next(uo, uu)) { const f32x4* sq = (const f32x4*)((const float*)(p.ws + WS_SSQ) + (size_t)(uu.row0 + (t_ & 255)) * 8); const f32x4 a = sq[0], c = sq[1];
                  ra[t_] = 1.f / sqrtf((((a.x + a.y) + (a.z + a.w)) + ((c.x + c.y) + (c.z + c.w))) * (1.f / DA) + RMS_EPS); } }
            __syncthreads();
            pg8::EpiResBf16 E{(const bf16_t*)(p.ws + WS_HB), (bf16_t*)p.out, D, ALPHA, (float*)(p.ws + WS_STATP), ra};
            pg8::gemm_phase<pg8::EpiResBf16, pg8::StaticOrder, false, PG8_ALIGN, true>(lds, wave, D, PP, S, E);
        } else if (sub == 3) {
            LAS unsigned short* wh = (LAS unsigned short*)lds; LAS unsigned short* wlo = wh + NE * D;
            { u32x4 t[16];
#pragma unroll
              for (int i = 0; i < 16; ++i) t[i] = *(const u32x4*)(p.ws + WS_WRT + (size_t)(i * NWAVES * 64 + tid) * 16);
#pragma unroll
              for (int i = 0; i < 16; ++i) *(LAS u32x4*)(lds + (i * NWAVES * 64 + tid) * 16) = t[i]; }
            LAS float* gbl = (LAS float*)(lds + GB_OFF);
            if (tid < 256) *(LAS f32x4*)(gbl + 4 * tid) = *(const f32x4*)(p.ln_mix_g + l * D + 4 * tid); else *(LAS f32x4*)(gbl + D + 4 * (tid - 256)) = *(const f32x4*)(p.ln_mix_b + l * D + 4 * (tid - 256));
            LAS int* lcnt = (LAS int*)(lds + RT_OFF); LAS int* gbase = lcnt + 32; LAS unsigned* rinfo = (LAS unsigned*)(lds + RT_OFF + 256);
            LAS float* rbs = (LAS float*)(lds + RT_OFF + 3584);
            if (tid < 32) { lcnt[tid] = 0; rbs[tid] = p.router_b[tid]; }
            __syncthreads();
            const bool dryr = (nrep == 2 && rep == 0);
            int li = 0;
            for (int tile = gw; tile < T / 16; tile += NGW, ++li) {
                const int c16 = lane & 15, kq = lane >> 4, mrow = 16 * tile + c16;
                float mean, rstd;
                { const f32x4* pp = (const f32x4*)((const float*)(p.ws + WS_STATP) + (size_t)mrow * 32); float s1 = 0.f, s2 = 0.f;
#pragma unroll
                  for (int j = 0; j < 8; ++j) { const f32x4 t = pp[j]; s1 += t.x + t.z; s2 += t.y + t.w; }
                  mean = s1 * (1.f / D); rstd = 1.f / sqrtf(fmaxf(s2 * (1.f / D) - mean * mean, 0.f) + LN_EPS); }
                const bf16_t* vrow = (const bf16_t*)p.out + (size_t)mrow * D + 8 * kq;
                bf16_t* hrow = (bf16_t*)(p.ws + WS_H1B) + (size_t)mrow * D + 8 * kq;
                LAS const unsigned char* whb = (LAS const unsigned char*)wh; LAS const unsigned char* wlb = (LAS const unsigned char*)wlo;
                f32x4 acc0 = (f32x4){0.f, 0.f, 0.f, 0.f}, acc1 = acc0;
                u32x4 pq[8];
#pragma unroll
                for (int d = 0; d < 8; ++d) pq[d] = *(const u32x4*)(vrow + 32 * d);
#pragma unroll
                for (int s = 0; s < 32; ++s) {
                    const u32x4 rv = pq[s & 7];
                    if (s + 8 < 32) pq[s & 7] = *(const u32x4*)(vrow + 32 * (s + 8));
                    const f32x4 v0 = (f32x4){bf2f(rv.x & 0xffffu), bf2f(rv.x >> 16), bf2f(rv.y & 0xffffu), bf2f(rv.y >> 16)}, v1 = (f32x4){bf2f(rv.z & 0xffffu), bf2f(rv.z >> 16), bf2f(rv.w & 0xffffu), bf2f(rv.w >> 16)};
                    const f32x4 g0 = *(const LAS f32x4*)(gbl + 32 * s + 8 * kq), g1 = *(const LAS f32x4*)(gbl + 32 * s + 8 * kq + 4);
                    const f32x4 b0 = *(const LAS f32x4*)(gbl + D + 32 * s + 8 * kq), b1 = *(const LAS f32x4*)(gbl + D + 32 * s + 8 * kq + 4);
                    const f32x4 h0 = (v0 - mean) * rstd * g0 + b0, h1 = (v1 - mean) * rstd * g1 + b1;
                    u32x4 ah, al;
                    ah.x = sb::cvtpk(h0.x, h0.y); ah.y = sb::cvtpk(h0.z, h0.w); ah.z = sb::cvtpk(h1.x, h1.y); ah.w = sb::cvtpk(h1.z, h1.w);
                    al.x = sb::cvtpk(h0.x - __builtin_bit_cast(float, ah.x << 16), h0.y - __builtin_bit_cast(float, ah.x & 0xffff0000u));
                    al.y = sb::cvtpk(h0.z - __builtin_bit_cast(float, ah.y << 16), h0.w - __builtin_bit_cast(float, ah.y & 0xffff0000u));
                    al.z = sb::cvtpk(h1.x - __builtin_bit_cast(float, ah.z << 16), h1.y - __builtin_bit_cast(float, ah.z & 0xffff0000u));
                    al.w = sb::cvtpk(h1.z - __builtin_bit_cast(float, ah.w << 16), h1.w - __builtin_bit_cast(float, ah.w & 0xffff0000u));
                    *(u32x4*)(hrow + 32 * s) = ah;
                    const int boff = c16 * (D * 2) + (((4 * s + kq) ^ c16) << 4);
                    const bf16x8 bh0 = *(const LAS bf16x8*)(whb + boff), bh1 = *(const LAS bf16x8*)(whb + boff + 16 * D * 2);
                    const bf16x8 bl0 = *(const LAS bf16x8*)(wlb + boff), bl1 = *(const LAS bf16x8*)(wlb + boff + 16 * D * 2);
                    const bf16x8 ahv = __builtin_bit_cast(bf16x8, ah), alv = __builtin_bit_cast(bf16x8, al);
                    acc0 = __builtin_amdgcn_mfma_f32_16x16x32_bf16(ahv, bh0, acc0, 0, 0, 0); acc1 = __builtin_amdgcn_mfma_f32_16x16x32_bf16(ahv, bh1, acc1, 0, 0, 0);
                    acc0 = __builtin_amdgcn_mfma_f32_16x16x32_bf16(ahv, bl0, acc0, 0, 0, 0); acc1 = __builtin_amdgcn_mfma_f32_16x16x32_bf16(ahv, bl1, acc1, 0, 0, 0);
                    acc0 = __builtin_amdgcn_mfma_f32_16x16x32_bf16(alv, bh0, acc0, 0, 0, 0); acc1 = __builtin_amdgcn_mfma_f32_16x16x32_bf16(alv, bh1, acc1, 0, 0, 0);
                }
                LAS float* lg = (LAS float*)(lds + LG16_OFF) + wave * 512;
#pragma unroll
                for (int i = 0; i < 4; ++i) { lg[(4 * kq + i) * 32 + c16] = acc0[i]; lg[(4 * kq + i) * 32 + 16 + c16] = acc1[i]; }
                if (lane < 16) {
                    const LAS float* L = lg + lane * 32;
                    float sc[32], sel[32];
#pragma unroll
                    for (int e = 0; e < 32; ++e) { sc[e] = 1.f / (1.f + __expf(-L[e])); sel[e] = sc[e] + rbs[e]; }
                    int g = 0; float best = -3.0e38f;
#pragma unroll
                    for (int j = 0; j < 8; ++j) {
                        const float s0 = sel[4 * j], s1_ = sel[4 * j + 1], s2_ = sel[4 * j + 2], s3 = sel[4 * j + 3];
                        const float gs = fmaxf(fmaxf(fmaxf(s0 + s1_, s0 + s2_), fmaxf(s0 + s3, s1_ + s2_)), fmaxf(s1_ + s3, s2_ + s3));
                        if (gs > best) { best = gs; g = j; }
                    }
                    float uu[4], ss[4];
#pragma unroll
                    for (int k = 0; k < 4; ++k) { uu[k] = sel[k]; ss[k] = sc[k]; }
#pragma unroll
                    for (int j = 1; j < 8; ++j) if (g == j) {
#pragma unroll
                        for (int k = 0; k < 4; ++k) { uu[k] = sel[4 * j + k]; ss[k] = sc[4 * j + k]; } }
                    int i0 = 0; float b0 = uu[0], w0r = ss[0];
#pragma unroll
                    for (int k = 1; k < 4; ++k) if (uu[k] > b0) { b0 = uu[k]; i0 = k; w0r = ss[k]; }
                    int i1 = -1; float b1 = -3.0e38f, w1r = 0.f;
#pragma unroll
                    for (int k = 0; k < 4; ++k) if (k != i0 && uu[k] > b1) { b1 = uu[k]; i1 = k; w1r = ss[k]; }
                    const float inv = 1.f / (w0r + w1r);
                    if (!dryr) {
                        const int e0 = 4 * g + i0, e1 = 4 * g + i1;
                        const int lp0 = __hip_atomic_fetch_add(&lcnt[e0], 1, __ATOMIC_RELAXED, __HIP_MEMORY_SCOPE_WORKGROUP), lp1 = __hip_atomic_fetch_add(&lcnt[e1], 1, __ATOMIC_RELAXED, __HIP_MEMORY_SCOPE_WORKGROUP);
                        LAS unsigned* ri = rinfo + ((li * NWAVES + wave) * 16 + lane) * 6;
                        ri[0] = (unsigned)e0; ri[1] = (unsigned)e1; ri[2] = (unsigned)lp0; ri[3] = (unsigned)lp1; ri[4] = __builtin_bit_cast(unsigned, w0r * inv); ri[5] = __builtin_bit_cast(unsigned, w1r * inv);
                    }
                }
            }
            __syncthreads();
            {
            if (tid < 32) gbase[tid] = (int)atomicAdd(&ctl[CW_CNT + 64 * l + tid], (unsigned)lcnt[tid]);
            __syncthreads();
            if (tid < li * NWAVES * 16 && !(nrep == 2 && rep == 0)) {
                const int row = 16 * (vcu * NWAVES + ((tid >> 4) & 7) + (tid >> 7) * NGW) + (tid & 15);
                const LAS unsigned* ri = rinfo + tid * 6;
                const int e0 = (int)ri[0], e1 = (int)ri[1]; const unsigned p0 = (unsigned)gbase[e0] + ri[2], p1 = (unsigned)gbase[e1] + ri[3];
                int* list = (int*)(p.ws + WS_LIST);
                list[(size_t)e0 * T + p0] = row; list[(size_t)e1 * T + p1] = row;
                u32x4 a; a.x = (unsigned)e0; a.y = (unsigned)e1; a.z = p0; a.w = p1;
                unsigned* rt = (unsigned*)(p.ws + WS_ROUTE) + (size_t)row * 8;
                *(u32x4*)rt = a; rt[4] = ri[4]; rt[5] = ri[5];
            } }
            __syncthreads();
        } else if (sub == 4 || sub == 5) {
            if (tab_layer != l) { moe_tables(ctl, l, wave, tabS, tabC, tabE); tab_layer = l; }
            MoeSched S; S.tabS = tabS; S.tabE = tabE; S.tabC = tabC; S.G = G; S.vcu = vcu; S.npn = 4; S.list = (const int*)(p.ws + WS_LIST);
            if (sub == 4) {
                S.down = false; S.A = (const char*)(p.ws + WS_H1B); S.W = (const char*)(p.ws + WS_WGU) + (size_t)l * NE * 1024 * 1024 * 2;
                pg8::EpiSiluMul E{(bf16_t*)(p.ws + WS_HID), DEXP};
                { pg8::Unit uu{}; const int t_ = tid;
                  for (int i = 0; i < 8 && S.next(i, uu); ++i) if (t_ < 256) *(LAS int*)(lds + TOKT_OFF + i * 1024 + t_ * 4) = uu.rl[t_ < uu.nvalid ? t_ : 0]; }
                __syncthreads();
                pg8::gemm_phase<pg8::EpiSiluMul, MoeSched, true>(lds, wave, D, D, S, E);
            } else {
                S.down = true; S.A = (const char*)(p.ws + WS_HID); S.W = (const char*)(p.ws + WS_WD) + (size_t)l * NE * 1024 * 512 * 2;
                pg8::EpiStoreFp8 E{p.ws + WS_Y, D, Y_SCALE};
                pg8::gemm_phase<pg8::EpiStoreFp8, MoeSched, false>(lds, wave, DEXP, DEXP, S, E);
            }
        } else {
            if (tab_layer != l) { moe_tables(ctl, l, wave, tabS, tabC, tabE); tab_layer = l; }
            const int nrows = (T - gw + NGW - 1) / NGW;
            f32x4 gg[4], bb[4];
#pragma unroll
            for (int j = 0; j < 4; ++j) { const int c = 512 * (j >> 1) + 8 * lane + 4 * (j & 1); gg[j] = *(const f32x4*)(p.ln_ffn_g + l * D + c); bb[j] = *(const f32x4*)(p.ln_ffn_b + l * D + c); }
            const bool lastl = (l == DEPTH - 1);
            u32x4 ri_a, ri_b; unsigned wa0, wa1, wb0, wb1;
            u32x4 da[4], db[4]; float fa0, fa1, fb0, fb1;
#define CMB_ROUTE(RI, W0, W1, mm) do { const unsigned* rt_ = (const unsigned*)(p.ws + WS_ROUTE) + (size_t)(mm) * 8; RI = *(const u32x4*)rt_; W0 = rt_[4]; W1 = rt_[5]; } while (0)
#define CMB_DATA(DD, RI, mm) do { const unsigned char* y0_ = p.ws + WS_Y + (size_t)(tabS[RI.x] * 256 + (int)RI.z) * D + 8 * lane; \
                const unsigned char* y1_ = p.ws + WS_Y + (size_t)(tabS[RI.y] * 256 + (int)RI.w) * D + 8 * lane; const bf16_t* h1_ = (const bf16_t*)(p.ws + WS_H1B) + (size_t)(mm) * D + 8 * lane; \
                DD[0] = *(const u32x4*)(h1_); DD[1] = *(const u32x4*)(h1_ + 512); const u32x2 ya_ = *(const u32x2*)(y0_), yb_ = *(const u32x2*)(y0_ + 512), yc_ = *(const u32x2*)(y1_), yd_ = *(const u32x2*)(y1_ + 512); \
                DD[2] = (u32x4){ya_.x, ya_.y, yb_.x, yb_.y}; DD[3] = (u32x4){yc_.x, yc_.y, yd_.x, yd_.y}; } while (0)
            { u32x4 r0; unsigned w0_, w1_;
              CMB_ROUTE(r0, w0_, w1_, gw); fa0 = __builtin_bit_cast(float, w0_); fa1 = __builtin_bit_cast(float, w1_); CMB_DATA(da, r0, gw);
              if (nrows > 1) { CMB_ROUTE(r0, w0_, w1_, gw + NGW); fb0 = __builtin_bit_cast(float, w0_); fb1 = __builtin_bit_cast(float, w1_); CMB_DATA(db, r0, gw + NGW); } else { fb0 = fb1 = 0.f;
#pragma unroll
                  for (int j = 0; j < 4; ++j) db[j] = da[j]; }
              if (nrows > 2) CMB_ROUTE(ri_a, wa0, wa1, gw + 2 * NGW); else { ri_a = r0; wa0 = wa1 = 0u; }
              if (nrows > 3) CMB_ROUTE(ri_b, wb0, wb1, gw + 3 * NGW); else { ri_b = r0; wb0 = wb1 = 0u; } }
            for (int i = 0; i < nrows; ++i) {
                const int m = gw + i * NGW;
                u32x4 d[4];
#pragma unroll
                for (int j = 0; j < 4; ++j) { d[j] = da[j]; da[j] = db[j]; }
                const float w0 = fa0 * (1.f / Y_SCALE), w1 = fa1 * (1.f / Y_SCALE); fa0 = fb0; fa1 = fb1;
                if (i + 2 < nrows) { fb0 = __builtin_bit_cast(float, wa0); fb1 = __builtin_bit_cast(float, wa1); CMB_DATA(db, ri_a, m + 2 * NGW); }
                ri_a = ri_b; wa0 = wb0; wa1 = wb1;
                if (i + 4 < nrows) CMB_ROUTE(ri_b, wb0, wb1, m + 4 * NGW);
                f32x4 v[4]; float s1 = 0.f, s2 = 0.f;
#pragma unroll
                for (int j = 0; j < 4; ++j) {
                    const int pc = j >> 1, hq = j & 1;
                    const unsigned h_lo = hq ? d[pc].z : d[pc].x, h_hi = hq ? d[pc].w : d[pc].y;
                    const unsigned ya = pc ? (hq ? d[2].w : d[2].z) : (hq ? d[2].y : d[2].x), yb = pc ? (hq ? d[3].w : d[3].z) : (hq ? d[3].y : d[3].x);
                    const f32x2_pk a01 = __builtin_amdgcn_cvt_pk_f32_fp8((int)ya, false), a23 = __builtin_amdgcn_cvt_pk_f32_fp8((int)ya, true), b01 = __builtin_amdgcn_cvt_pk_f32_fp8((int)yb, false), b23 = __builtin_amdgcn_cvt_pk_f32_fp8((int)yb, true);
                    v[j].x = ALPHA * bf2f(h_lo & 0xffffu) + w0 * a01.x + w1 * b01.x;
                    v[j].y = ALPHA * bf2f(h_lo >> 16) + w0 * a01.y + w1 * b01.y;
                    v[j].z = ALPHA * bf2f(h_hi & 0xffffu) + w0 * a23.x + w1 * b23.x;
                    v[j].w = ALPHA * bf2f(h_hi >> 16) + w0 * a23.y + w1 * b23.y;
                    s1 += (v[j].x + v[j].y) + (v[j].z + v[j].w); s2 += (v[j].x * v[j].x + v[j].y * v[j].y) + (v[j].z * v[j].z + v[j].w * v[j].w);
                }
                s1 = wave_sum(s1); s2 = wave_sum(s2);
                const float mean = s1 * (1.f / D), rstd = 1.f / sqrtf(fmaxf(s2 * (1.f / D) - mean * mean, 0.f) + LN_EPS);
                f32x4 o[4];
#pragma unroll
                for (int j = 0; j < 4; ++j) o[j] = (v[j] - mean) * rstd * gg[j] + bb[j];
                if (lastl) {
#pragma unroll
                    for (int j = 0; j < 4; ++j) *(f32x4*)(p.out + (size_t)m * D + 512 * (j >> 1) + 8 * lane + 4 * (j & 1)) = o[j];
                } else {
                    bf16_t* hb = (bf16_t*)(p.ws + WS_HB) + (size_t)m * D + 8 * lane;
                    u32x4 w; w.x = pk2(o[0].x, o[0].y); w.y = pk2(o[0].z, o[0].w); w.z = pk2(o[1].x, o[1].y); w.w = pk2(o[1].z, o[1].w); *(u32x4*)hb = w;
                    w.x = pk2(o[2].x, o[2].y); w.y = pk2(o[2].z, o[2].w); w.z = pk2(o[3].x, o[3].y); w.w = pk2(o[3].z, o[3].w); *(u32x4*)(hb + 512) = w;
                }
            }
#undef CMB_ROUTE
#undef CMB_DATA
        }
      }
    }
}

#undef tid
static int g_grid = 0;
static void mk_launch(const Ptrs& p, int lo, int hi, int li, hipStream_t stream) {
    Args a{}; a.p = p; a.ph_lo = lo; a.ph_hi = hi; a.li = li; a.pad = 0;
    hipLaunchKernelGGL(mk_fwd, dim3(g_grid), dim3(NWAVES * 64), LDS_BYTES, stream, a);
}

extern "C" void kernel_launch(void* const* d_in, const int* in_sizes, int n_in, void* d_out, int out_size, void* d_ws, size_t ws_size, hipStream_t stream) {
    if (n_in != 17 || out_size != T * D || ws_size < WS_END) { fprintf(stderr, "kernel_launch: unexpected shapes (n_in %d out %d ws %zu)\n", n_in, out_size, ws_size); return; }
    if (g_grid == 0) {
        int dev = 0, cus = 0;
        if (hipGetDevice(&dev) != hipSuccess || hipDeviceGetAttribute(&cus, hipDeviceAttributeMultiprocessorCount, dev) != hipSuccess) { g_grid = -1; return; }
        if (hipFuncSetAttribute((const void*)mk_fwd, hipFuncAttributeMaxDynamicSharedMemorySize, LDS_BYTES) != hipSuccess) { g_grid = -1; return; }
        int per_cu = 0;
        if (hipOccupancyMaxActiveBlocksPerMultiprocessor(&per_cu, (const void*)mk_fwd, NWAVES * 64, LDS_BYTES) != hipSuccess || per_cu < 1) { (void)hipGetLastError(); g_grid = -1; return; }
        g_grid = (cus == 256) ? cus : -1;
    }
    if (g_grid < 0) return;
    Ptrs p{};
    p.x = (const float*)d_in[0]; p.ln0_g = (const float*)d_in[1]; p.ln0_b = (const float*)d_in[2]; p.w_in = (const float*)d_in[3]; p.conv_w = (const float*)d_in[4];
    p.g_conv = (const float*)d_in[5]; p.g_attn = (const float*)d_in[6]; p.w_out = (const float*)d_in[7]; p.ln_mix_g = (const float*)d_in[8]; p.ln_mix_b = (const float*)d_in[9];
    p.router_w = (const float*)d_in[10]; p.router_b = (const float*)d_in[11]; p.w_gate = (const float*)d_in[12]; p.w_up = (const float*)d_in[13]; p.w_down = (const float*)d_in[14];
    p.ln_ffn_g = (const float*)d_in[15]; p.ln_ffn_b = (const float*)d_in[16]; p.out = (float*)d_out; p.ws = (unsigned char*)d_ws;
    (void)hipMemsetAsync((char*)d_ws + WS_CTL, 0, CTL_BYTES, stream);
#if MK_MODE == 0
    for (int ph = 0; ph < N_PHASES; ++ph) mk_launch(p, ph, ph + 1, ph, stream);
#else
    mk_launch(p, 0, N_PHASES, 0, stream);
#endif
}
```

```cpp
#include <hip/hip_runtime.h>
#include <cstdint>
#include <cstdio>
#ifndef PROBE_MASK
#define PROBE_MASK 0
#endif
#ifndef MK_MODE
#define MK_MODE 1
#endif

constexpr int T = 32768, D = 1024, SEQ = 4096, NBATCH = 8, DEPTH = 2;
constexpr int DC = 512, DA = 512, HD = 64, NH = 8, NPROJ = 3072;
constexpr int NE = 32, NG = 8, EPG = 4, DEXP = 512;
constexpr float ALPHA = 1.41421356237f;
constexpr float LN_EPS = 1e-5f, RMS_EPS = 1e-6f;
constexpr float Y_SCALE = 16.f;
constexpr float QSCALE = 0.125f * 1.4426950408889634f;
constexpr float LN2 = 0.6931471805599453f;
constexpr int PP = 2560, PO_Q = 0, PO_B = 512, PO_U = 1024, PO_K = 1536, PO_V = 2048;

constexpr size_t MiB = 1u << 20;
constexpr size_t WS_CTL = 0, CTL_BYTES = 1 * MiB;
constexpr size_t WS_ROUTE = 1 * MiB;
constexpr size_t WS_LIST = 2 * MiB;
constexpr size_t WS_WIN = 6 * MiB, WS_WOUT = 18 * MiB, WS_WGU = 22 * MiB, WS_WD = 150 * MiB;
constexpr size_t WS_PROJ = 214 * MiB;
constexpr size_t WS_HB = 406 * MiB;
constexpr size_t WS_H1B = 470 * MiB;
constexpr size_t WS_VI = WS_PROJ + 160 * MiB;
constexpr size_t WS_QKI = WS_H1B;
constexpr size_t WS_STATP = 534 * MiB;
constexpr size_t WS_WRT = 538 * MiB;
constexpr size_t WS_SSQ = 539 * MiB;
constexpr size_t WS_END = 540 * MiB;
constexpr size_t WS_Y = WS_PROJ;
constexpr size_t WS_HID = WS_PROJ + 144 * MiB;
constexpr int CW_CNT = 1024;

typedef unsigned short bf16_t;
typedef float f32x4 __attribute__((ext_vector_type(4)));
typedef unsigned u32x4 __attribute__((ext_vector_type(4)));
typedef unsigned u32x2 __attribute__((ext_vector_type(2)));

__device__ __forceinline__ unsigned f2bf(float f) { unsigned u = __builtin_bit_cast(unsigned, f); return (u + 0x7fffu + ((u >> 16) & 1u)) >> 16; }
__device__ __forceinline__ float bf2f(unsigned b) { return __builtin_bit_cast(float, b << 16); }
typedef float f32x2_pk __attribute__((ext_vector_type(2))); typedef __bf16 bf16x2_pk __attribute__((ext_vector_type(2)));
__device__ __forceinline__ unsigned pk2(float lo, float hi) { f32x2_pk v = {lo, hi}; bf16x2_pk b = __builtin_convertvector(v, bf16x2_pk); return __builtin_bit_cast(unsigned, b); }
#define DPP_ADD(v, ctrl) ((v) + __builtin_bit_cast(float, __builtin_amdgcn_update_dpp(0, __builtin_bit_cast(int, (v)), (ctrl), 0xf, 0xf, false)))
__device__ __forceinline__ float wave_sum(float v) {
    v = DPP_ADD(v, 0xB1); v = DPP_ADD(v, 0x4E); v = DPP_ADD(v, 0x141); v = DPP_ADD(v, 0x140);
    const int iv = __builtin_bit_cast(int, v);
    const float r0 = __builtin_bit_cast(float, __builtin_amdgcn_readlane(iv, 0)), r1 = __builtin_bit_cast(float, __builtin_amdgcn_readlane(iv, 16)),
                r2 = __builtin_bit_cast(float, __builtin_amdgcn_readlane(iv, 32)), r3 = __builtin_bit_cast(float, __builtin_amdgcn_readlane(iv, 48));
    return (r0 + r1) + (r2 + r3);
}

struct Ptrs {
    const float *x, *ln0_g, *ln0_b, *w_in, *conv_w, *g_conv, *g_attn, *w_out, *ln_mix_g, *ln_mix_b, *router_w, *router_b, *w_gate, *w_up, *w_down, *ln_ffn_g, *ln_ffn_b;
    float* out; unsigned char* ws;
};

__device__ __forceinline__ void unpack8(const u32x4 v, float* f) {
    f[0] = bf2f(v.x & 0xffffu); f[1] = bf2f(v.x >> 16); f[2] = bf2f(v.y & 0xffffu); f[3] = bf2f(v.y >> 16);
    f[4] = bf2f(v.z & 0xffffu); f[5] = bf2f(v.z >> 16); f[6] = bf2f(v.w & 0xffffu); f[7] = bf2f(v.w >> 16);
}


#define GAS __attribute__((address_space(1)))
#define LAS __attribute__((address_space(3)))
typedef short bf16x8 __attribute__((ext_vector_type(8)));
typedef GAS unsigned gu32;
#define RLX_AGENT __ATOMIC_RELAXED, __HIP_MEMORY_SCOPE_AGENT
#define LDS_WAIT() asm volatile("s_waitcnt lgkmcnt(0)" ::: "memory")
#define VM_WAIT() asm volatile("s_waitcnt vmcnt(0)" ::: "memory")

constexpr int NWAVES = 8;
constexpr int RING_BYTES = 131072;
constexpr int LDSCTL_OFF = RING_BYTES;
constexpr int MISC_OFF = LDSCTL_OFF + 64;
constexpr int TAB_OFF = LDSCTL_OFF + 256;
constexpr int TOKT_OFF = RING_BYTES + 8192;
constexpr int LDS_BYTES = 163840;
constexpr int CW_XMIS = 2040;
constexpr int CW_RDYW = 3584;
constexpr int CW_RDYA = 3072;
constexpr int CW_RDY = 2048;
constexpr int CW_BAR = 4096;
constexpr int N_PHASES = 1 + 7 * DEPTH;

__device__ __forceinline__ int lane_id_v() { int l; asm volatile("v_mbcnt_lo_u32_b32 %0, -1, 0\n\tv_mbcnt_hi_u32_b32 %0, -1, %0" : "=v"(l)); return l; }
#define XB_TMO      128
#define XB_XCNT(j)  (256  + 64 * (j))
#define XB_XSUB(j)  (1280 + 64 * (j))
#define XB_XGEN(j)  (2304 + 64 * (j))
#define XB_TOP      3328
#define XB_TOPGEN   3392
#define XCD_BAR_WORDS 3456
constexpr size_t CTL_USED_BYTES = (size_t)(CW_BAR + (N_PHASES + 1) * XCD_BAR_WORDS) * 4;
static_assert(CTL_USED_BYTES <= CTL_BYTES, "control area");
#define XB_SPIN_CAP (1u << 18)
__device__ __forceinline__ unsigned xb_ld(unsigned* p)              { return __hip_atomic_load(p, __ATOMIC_RELAXED, __HIP_MEMORY_SCOPE_AGENT); }
__device__ __forceinline__ unsigned xb_add(unsigned* p, unsigned v) { return __hip_atomic_fetch_add(p, v, __ATOMIC_RELAXED, __HIP_MEMORY_SCOPE_AGENT); }
__device__ __forceinline__ unsigned xb_xcc_id() { return (unsigned)__builtin_amdgcn_s_getreg((3 << 11) | 20) & 0xFu; }
#define XB_SPIN(cond, bar) do { unsigned _sp = 0; while (cond) { __builtin_amdgcn_s_sleep(1); \
    if ((++_sp & 255u) == 0u) { if (xb_ld(&(bar)[XB_TMO])) break; if (_sp > XB_SPIN_CAP) { atomicAdd(&(bar)[XB_TMO], 1u); break; } } } } while (0)
struct XcdBarrier { unsigned* bar; unsigned x; volatile LAS unsigned* st; };
__device__ __forceinline__ XcdBarrier xcd_barrier_post(unsigned* bar, volatile LAS unsigned* st) {
    XcdBarrier b; b.bar = bar; b.x = xb_xcc_id(); b.st = st;
    if (threadIdx.x == 0) (void)xb_add(&bar[XB_XCNT(b.x)], 1u);
    return b;
}
__device__ __forceinline__ void xcd_barrier_complete(unsigned* bar, unsigned x, unsigned& nloc, unsigned& nx) {
    const unsigned G = gridDim.x * gridDim.y * gridDim.z;
    unsigned sum, cnt, mine, sp = 0u;
    for (;;) {
        sum = 0u; cnt = 0u; mine = 0u;
#pragma unroll
        for (unsigned j = 0; j < 16; ++j) { const unsigned c = xb_ld(&bar[XB_XCNT(j)]); sum += c; cnt += (c > 0u) ? 1u : 0u; mine = (j == x) ? c : mine; }
        if (sum == G) break;
        __builtin_amdgcn_s_sleep(1);
        if ((++sp & 255u) == 0u) { if (xb_ld(&bar[XB_TMO])) break; if (sp > XB_SPIN_CAP) { atomicAdd(&bar[XB_TMO], 1u); break; } }
    }
    nloc = mine > 0u ? mine : 1u; nx = cnt > 0u ? cnt : 1u;
}
__device__ __forceinline__ void xcd_barrier(const XcdBarrier& b, const int wave_id  ) {
    asm volatile("s_waitcnt vmcnt(0)" ::: "memory");
    __syncthreads();
    if (wave_id == 0 && lane_id_v() == 0) {
        unsigned* bar = b.bar;
        __builtin_amdgcn_s_waitcnt(0);
        unsigned nloc = b.st[0], nx = b.st[1];
        if (nloc == 0u) { xcd_barrier_complete(bar, b.x, nloc, nx); b.st[0] = nloc; b.st[1] = nx; }
        const unsigned old = xb_add(&bar[XB_XSUB(b.x)], 1u);
        const unsigned gen = old / nloc;
        if (old + 1u == (gen + 1u) * nloc) {
            __builtin_amdgcn_fence(__ATOMIC_RELEASE, "agent");
            asm volatile("s_waitcnt vmcnt(0)" ::: "memory");
            const unsigned og = xb_add(&bar[XB_TOP], 1u);
            const unsigned tg = og / nx;
            if (og + 1u == (tg + 1u) * nx) xb_add(&bar[XB_TOPGEN], 1u);
            else XB_SPIN(xb_ld(&bar[XB_TOPGEN]) == tg, bar);
            __builtin_amdgcn_fence(__ATOMIC_ACQUIRE, "agent");
            xb_add(&bar[XB_XGEN(b.x)], 1u);
            asm volatile("s_waitcnt vmcnt(0)" ::: "memory");
        } else {
            XB_SPIN(xb_ld(&bar[XB_XGEN(b.x)]) == gen, bar);
            __builtin_amdgcn_fence(__ATOMIC_ACQUIRE, "agent");
            asm volatile("s_waitcnt vmcnt(0)" ::: "memory");
        }
    }
    __syncthreads();
}

namespace pg8 {
constexpr int BM = 256, BK = 64, HALF = 128, HTB = HALF * BK * 2, STAGE_BYTES = 8 * HTB, NXCD = 8, WGM = 4;
__host__ __device__ __forceinline__ int lds_byte(int r, int c) { const int st = (r >> 4) * 2 + (c >> 5), rr = r & 15, cc = c & 31, ob = rr * 64 + cc * 2; return st * 1024 + (ob ^ (((ob >> 9) & 1) << 5)); }
__host__ __device__ __forceinline__ void stage_rc(int b, int& R, int& C) { const int st = b / 1024, sb = b % 1024, swz = sb ^ (((sb >> 9) & 1) << 5); R = (st >> 1) * 16 + swz / 64; C = (st & 1) * 32 + (swz % 64) / 2; }
__host__ __device__ __forceinline__ int perm32(int rho) { const int n = rho >> 4, i = rho & 15; return 8 * (i >> 2) + 4 * n + (i & 3); }

struct Unit { int pm, pn; const char* a; const char* b; const int* rl; int nvalid; int row0; int half; int rlds; int need; };

struct StaticOrder {          static constexpr bool HAS_HALF = false;
    int nM, nN, nwg, G, c, r0, r1; const char* A; const char* Bt; size_t astep, bstep;
    __device__ __forceinline__ void init(const void* A_, int lda, const void* Bt_, int M, int N, int K, int G_, int c_) { nM = M / BM; nN = N / BM; nwg = nM * nN; G = G_; c = c_; r0 = 0; r1 = 1 << 30; A = (const char*)A_; Bt = (const char*)Bt_; astep = (size_t)BM * lda * 2; bstep = (size_t)BM * K * 2; }
    __device__ __forceinline__ bool next(int i_, Unit& u) const {
        const int i = i_ + r0; if (i >= r1) return false;
        const long L = (long)i * G + c; if (L >= nwg) return false;
        int wgid = (int)L; { const int q = nwg / NXCD, r = nwg % NXCD, xcd = wgid % NXCD, off = wgid / NXCD; wgid = (xcd < r ? xcd * (q + 1) : r * (q + 1) + (xcd - r) * q) + off; }
        const int nig = WGM * nN, gid = wgid / nig, fm = gid * WGM, gsz = (nM - fm) < WGM ? (nM - fm) : WGM;
        u.pm = fm + ((wgid % nig) % gsz); u.pn = (wgid % nig) / gsz; u.a = A + (size_t)u.pm * astep; u.b = Bt + (size_t)u.pn * bstep; u.rl = nullptr; u.nvalid = 0; u.row0 = u.pm * BM; u.half = 0; u.rlds = 0; u.need = 0; return true;
    }
};

struct WoutOrder {            static constexpr bool HAS_HALF = false;
    int nwg, G, c; const char* A; const char* Bt; size_t astep, bstep; unsigned* rdy;
    __device__ __forceinline__ void signal_rb(int rb) const {
        if (lane_id_v() == 0) (void)xb_add(rdy + (CW_RDYW - CW_RDYA) + rb, 1u);
    }
    __device__ __forceinline__ bool next(int i, Unit& u) const {
        const int L = i * G + c; if (L >= nwg) return false;
        u.pm = L >> 2; u.pn = L & 3; u.a = A + (size_t)u.pm * astep; u.b = Bt + (size_t)u.pn * bstep; u.rl = nullptr; u.nvalid = 0; u.row0 = u.pm * BM; u.half = 0; u.rlds = 0; u.need = 4; return true;
    }
};
typedef float f32x2_e __attribute__((ext_vector_type(2)));
__device__ __forceinline__ unsigned cvt_pk_bf16(float lo, float hi) { unsigned r; asm volatile("v_cvt_pk_bf16_f32 %0, %1, %2" : "=v"(r) : "v"(lo), "v"(hi)); return r; }

struct EpiStoreBf16 {
    static constexpr bool PERM = true;
    bf16_t* O; int ldc;
    __device__ __forceinline__ void operator()(const f32x4 (&acc)[2][2][4][2], const Unit& u, int wr, int wc, int fr, int fq) const {
        const int row0 = u.row0 + wr * 64 + fr, col0 = u.pn * BM + wc * 32 + 8 * fq;
#pragma unroll
        for (int ai = 0; ai < 2; ++ai)
#pragma unroll
            for (int m = 0; m < 4; ++m) { if ((ai == 1 && (u.half || u.nvalid <= HALF)) || (wr == 1 && u.nvalid <= 64 + ai * HALF)) continue;     bf16_t* rowp = O + (size_t)(row0 + ai * HALF + m * 16) * ldc + col0;
#pragma unroll
                for (int bj = 0; bj < 2; ++bj) { const f32x4 v0 = acc[ai][bj][m][0], v1 = acc[ai][bj][m][1];
                    u32x4 w; w.x = cvt_pk_bf16(v0[0], v0[1]); w.y = cvt_pk_bf16(v0[2], v0[3]); w.z = cvt_pk_bf16(v1[0], v1[1]); w.w = cvt_pk_bf16(v1[2], v1[3]);
                    *(u32x4*)(rowp + bj * HALF) = w; } }
    }
};
struct EpiStoreFp8 {
    static constexpr bool PERM = true;
    static constexpr int BH_ROWS = 8;
    static constexpr int FLOW = 2;
    static constexpr bool A_IL = true;
    static __host__ __device__ __forceinline__ int bmap(int R) { return (R >> 5) * 64 + ((R & 15) >> 2) * 16 + ((R >> 4) & 1) * 4 + (R & 3); }
    unsigned char* O; int ldc; float scale;
    __device__ __forceinline__ void operator()(const f32x4 (&acc)[2][2][4][2], const Unit& u, int wr, int wc, int fr, int fq) const {
        const int row0 = u.row0 + wr * 64 + fr, col0 = u.pn * BM + wc * 64 + 16 * fq;
#pragma unroll
        for (int ai = 0; ai < 2; ++ai)
#pragma unroll
            for (int m = 0; m < 4; ++m) { if ((ai == 1 && (u.half || u.nvalid <= HALF)) || (wr == 1 && u.nvalid <= 64 + ai * HALF)) continue;     unsigned char* rowp = O + (size_t)(row0 + ai * HALF + m * 16) * ldc + col0;
                u32x4 w;
#pragma unroll
                for (int bj = 0; bj < 2; ++bj) { f32x4 v0 = acc[ai][bj][m][0] * scale, v1 = acc[ai][bj][m][1] * scale;
#pragma unroll
                    for (int q = 0; q < 4; ++q) { v0[q] = __builtin_fminf(__builtin_fmaxf(v0[q], -240.f), 240.f); v1[q] = __builtin_fminf(__builtin_fmaxf(v1[q], -240.f), 240.f); }
                    int w0 = __builtin_amdgcn_cvt_pk_fp8_f32(v0[0], v0[1], 0, false); w0 = __builtin_amdgcn_cvt_pk_fp8_f32(v0[2], v0[3], w0, true);
                    int w1 = __builtin_amdgcn_cvt_pk_fp8_f32(v1[0], v1[1], 0, false); w1 = __builtin_amdgcn_cvt_pk_fp8_f32(v1[2], v1[3], w1, true);
                    if (bj == 0) { w.x = (unsigned)w0; w.y = (unsigned)w1; } else { w.z = (unsigned)w0; w.w = (unsigned)w1; } }
                *(u32x4*)rowp = w; }
    }
};
struct EpiInProj {
    static constexpr bool PERM = true;
    bf16_t* O; int ldc; bf16_t* QK; bf16_t* VI;
    __device__ __forceinline__ void operator()(const f32x4 (&acc)[2][2][4][2], const Unit& u, int wr, int wc, int fr, int fq) const {
        const int row0 = u.row0 + wr * 64 + fr;
        if (u.pn >= 4 && u.pn < 8) {
            const int col0 = 1024 + (u.pn - 4) * HALF + wc * 32 + 8 * fq;
#pragma unroll
            for (int ai = 0; ai < 2; ++ai)
#pragma unroll
                for (int m = 0; m < 4; ++m) { const f32x4 c0 = acc[ai][0][m][0], c1 = acc[ai][0][m][1], x0 = acc[ai][1][m][0], x1 = acc[ai][1][m][1];
                    u32x4 w; w.x = cvt_pk_bf16(c0[0] * x0[0], c0[1] * x0[1]); w.y = cvt_pk_bf16(c0[2] * x0[2], c0[3] * x0[3]); w.z = cvt_pk_bf16(c1[0] * x1[0], c1[1] * x1[1]); w.w = cvt_pk_bf16(c1[2] * x1[2], c1[3] * x1[3]);
                    *(u32x4*)(O + (size_t)(row0 + ai * HALF + m * 16) * ldc + col0) = w; }
        } else if (u.pn == 2 || u.pn == 3 || u.pn == 8 || u.pn == 9) {
            bf16_t* const hb = QK + (size_t)(u.pn >= 8 ? 8 : 0) * T * 64 + ((size_t)(4 * (u.pn & 1) + (wc >> 1)) * T) * 64 + (((wc & 1) * 2 + (fq >> 1)) * 64) + 8 * (fq & 1);
#pragma unroll
            for (int ai = 0; ai < 2; ++ai)
#pragma unroll
                for (int m = 0; m < 4; ++m) { const int row = row0 + ai * HALF + m * 16; bf16_t* rowp = hb + (size_t)(row >> 2) * 256 + (row & 3) * 16;
#pragma unroll
                    for (int bj = 0; bj < 2; ++bj) { const f32x4 v0 = acc[ai][bj][m][0], v1 = acc[ai][bj][m][1];
                        u32x4 w; w.x = cvt_pk_bf16(v0[0], v0[1]); w.y = cvt_pk_bf16(v0[2], v0[3]); w.z = cvt_pk_bf16(v1[0], v1[1]); w.w = cvt_pk_bf16(v1[2], v1[3]);
                        *(u32x4*)(rowp + (size_t)(2 * bj) * T * 64) = w; } }
        } else if (u.pn >= 10) {
            bf16_t* const hb = VI + ((size_t)(4 * (u.pn & 1) + (wc >> 1)) * T) * 64 + (wc & 1) * 64 + 8 * fq;
#pragma unroll
            for (int ai = 0; ai < 2; ++ai)
#pragma unroll
                for (int m = 0; m < 4; ++m) { const int row = row0 + ai * HALF + m * 16; bf16_t* rowp = hb + (size_t)(row >> 1) * 128 + (row & 1) * 32;
#pragma unroll
                    for (int bj = 0; bj < 2; ++bj) { const f32x4 v0 = acc[ai][bj][m][0], v1 = acc[ai][bj][m][1];
                        u32x4 w; w.x = cvt_pk_bf16(v0[0], v0[1]); w.y = cvt_pk_bf16(v0[2], v0[3]); w.z = cvt_pk_bf16(v1[0], v1[1]); w.w = cvt_pk_bf16(v1[2], v1[3]);
                        *(u32x4*)(rowp + (size_t)(2 * bj) * T * 64) = w; } }
        } else {
            const int col0 = 512 + u.pn * BM + wc * 32 + 8 * fq;
#pragma unroll
            for (int ai = 0; ai < 2; ++ai)
#pragma unroll
                for (int m = 0; m < 4; ++m) { bf16_t* rowp = O + (size_t)(row0 + ai * HALF + m * 16) * ldc + col0;
#pragma unroll
                    for (int bj = 0; bj < 2; ++bj) { const f32x4 v0 = acc[ai][bj][m][0], v1 = acc[ai][bj][m][1];
                        u32x4 w; w.x = cvt_pk_bf16(v0[0], v0[1]); w.y = cvt_pk_bf16(v0[2], v0[3]); w.z = cvt_pk_bf16(v1[0], v1[1]); w.w = cvt_pk_bf16(v1[2], v1[3]);
                        *(u32x4*)(rowp + bj * HALF) = w; } }
        }
    }
};
struct EpiResBf16 {            static constexpr int FLOW = 1;
    static constexpr bool PERM = true;
    const bf16_t* res; bf16_t* out; int ldc; float alpha; float* statp; const LAS float* ra;
    __device__ __forceinline__ void mid(f32x4 (&acc)[2][2][4][2], int ui, int wr, int fr) const {
#pragma unroll
        for (int ai = 0; ai < 2; ++ai)
#pragma unroll
            for (int m = 0; m < 4; ++m) { const float f = ra[ui * BM + ai * HALF + wr * 64 + m * 16 + fr];
#pragma unroll
                for (int bj = 0; bj < 2; ++bj)
#pragma unroll
                    for (int n = 0; n < 2; ++n) acc[ai][bj][m][n] = acc[ai][bj][m][n] * f; }
    }
    __device__ __forceinline__ void operator()(const f32x4 (&acc)[2][2][4][2], const Unit& u, int wr, int wc, int fr, int fq) const {
        const int row0 = u.row0 + wr * 64 + fr, col0 = u.pn * BM + wc * 32 + 8 * fq;
#pragma unroll
        for (int ai = 0; ai < 2; ++ai) {
            u32x4 hv[4][2];
#pragma unroll
            for (int m = 0; m < 4; ++m)
#pragma unroll
                for (int bj = 0; bj < 2; ++bj) hv[m][bj] = __builtin_nontemporal_load((const u32x4*)(res + (size_t)(row0 + ai * HALF + m * 16) * ldc + col0 + bj * HALF));
            __builtin_amdgcn_sched_barrier(0);
            float s1[4], s2[4];
#pragma unroll
            for (int m = 0; m < 4; ++m) { const size_t off = (size_t)(row0 + ai * HALF + m * 16) * ldc + col0; s1[m] = 0.f; s2[m] = 0.f;
#pragma unroll
                for (int bj = 0; bj < 2; ++bj) { const u32x4 h4 = hv[m][bj]; const f32x4 a0 = acc[ai][bj][m][0], a1 = acc[ai][bj][m][1];
                    u32x4 w;
                    w.x = cvt_pk_bf16(alpha * bf2f(h4.x & 0xffffu) + a0[0], alpha * bf2f(h4.x >> 16) + a0[1]); w.y = cvt_pk_bf16(alpha * bf2f(h4.y & 0xffffu) + a0[2], alpha * bf2f(h4.y >> 16) + a0[3]);
                    w.z = cvt_pk_bf16(alpha * bf2f(h4.z & 0xffffu) + a1[0], alpha * bf2f(h4.z >> 16) + a1[1]); w.w = cvt_pk_bf16(alpha * bf2f(h4.w & 0xffffu) + a1[2], alpha * bf2f(h4.w >> 16) + a1[3]);
                    { const int rw_ = row0 + ai * HALF + m * 16;
                      *(u32x4*)(out + (size_t)(rw_ >> 1) * (2 * 1024) + (u.pn * 8 + wc + 4 * bj) * 64 + (rw_ & 1) * 32 + 8 * fq) = w; }
#pragma unroll
                    for (int q = 0; q < 4; ++q) { const float lo = bf2f(w[q] & 0xffffu), hi = bf2f(w[q] >> 16); s1[m] += lo + hi; s2[m] += lo * lo + hi * hi; } } }
#pragma unroll
            for (int o = 16; o < 64; o <<= 1) {
#pragma unroll
                for (int m = 0; m < 4; ++m) { s1[m] += __shfl_xor(s1[m], o); s2[m] += __shfl_xor(s2[m], o); } }
            if (fq == 0) {
#pragma unroll
                for (int m = 0; m < 4; ++m) { f32x2_e v; v.x = s1[m]; v.y = s2[m]; *(f32x2_e*)(statp + ((size_t)(u.pn * 4 + wc) * T + (row0 + ai * HALF + m * 16)) * 2) = v; } }
        }
    }
};
struct EpiSiluMul {            static constexpr int FLOW = 1;
    static constexpr bool PERM = true;
    bf16_t* O; int ldc;
    __device__ __forceinline__ void operator()(const f32x4 (&acc)[2][2][4][2], const Unit& u, int wr, int wc, int fr, int fq) const {
        const int row0 = u.row0 + wr * 64 + fr, col0 = u.pn * HALF + wc * 32 + 8 * fq;
#pragma unroll
        for (int ai = 0; ai < 2; ++ai)
#pragma unroll
            for (int m = 0; m < 4; ++m) { if ((ai == 1 && (u.half || u.nvalid <= HALF)) || (wr == 1 && u.nvalid <= 64 + ai * HALF)) continue;     const int rw_ = row0 + ai * HALF + m * 16;
                bf16_t* rowp = O + (size_t)(rw_ >> 1) * (2 * ldc) + (rw_ & 1) * 32 + (col0 >> 5) * 64 + (col0 & 31); float h[8];
#pragma unroll
                for (int n = 0; n < 2; ++n)
#pragma unroll
                    for (int j = 0; j < 4; ++j) { const float g = acc[ai][0][m][n][j], up = acc[ai][1][m][n][j]; h[4 * n + j] = g * __builtin_amdgcn_rcpf(1.f + __builtin_amdgcn_exp2f(-1.4426950408889634f * g)) * up; }
                u32x4 w; w.x = cvt_pk_bf16(h[0], h[1]); w.y = cvt_pk_bf16(h[2], h[3]); w.z = cvt_pk_bf16(h[4], h[5]); w.w = cvt_pk_bf16(h[6], h[7]);
                *(u32x4*)rowp = w; }
    }
};

#ifndef PG8_ALIGN
#define PG8_ALIGN true
#endif
template <class E_, class = void> struct BMap { static __device__ __forceinline__ int map(int R) { return E_::PERM ? ((R & ~31) + perm32(R & 31)) : R; } static constexpr int BH = HALF; };
template <class E_> struct BMap<E_, decltype((void)E_::BH_ROWS)> { static __device__ __forceinline__ int map(int R) { return E_::bmap(R); } static constexpr int BH = E_::BH_ROWS; };
template <class E_> __device__ __forceinline__ int bmap_of(int R) { return BMap<E_>::map(R); }
template <class E_, class = void> struct AIl { static constexpr bool v = false; };
template <class E_> struct AIl<E_, decltype((void)E_::A_IL)> { static constexpr bool v = E_::A_IL; };
template <class E_, class = void> struct Flow { static constexpr int v = 0; };
template <class E_> struct Flow<E_, decltype((void)E_::FLOW)> { static constexpr int v = E_::FLOW; };
template <class E_> __device__ __forceinline__ constexpr int bh_rows_of() { return BMap<E_>::BH; }
static_assert(BMap<EpiStoreFp8>::BH == 8 && BMap<EpiInProj>::BH == HALF, "B-row map selection");
template <class Epi, class Sched, bool GATHER, bool ALIGN_EPI = PG8_ALIGN, bool MIDK = false>
__device__ __forceinline__ void gemm_phase(LAS unsigned char* lds, const int wave_id  , const int K, const int lda, const Sched& S, const Epi& E) {
    int lane_ = lane_id_v();
    const int wid = wave_id, lane = lane_, tid = wid * 64 + lane, wr = wid >> 2, wc = wid & 3, fr = lane & 15, fq = lane >> 4;
    const int nt = K / BK;
    unsigned voffB[2], vA[2][2], nvA[2][2]; int Rr[2], Cb[2];
#pragma unroll
    for (int i = 0; i < 2; ++i) { int R, C; stage_rc(tid * 16 + i * 8192, R, C); const int Rb = bmap_of<Epi>(R);
        voffB[i] = (unsigned)(Rb * K + C) * 2u; Rr[i] = R; Cb[i] = C * 2;
        vA[0][i] = AIl<Epi>::v ? (unsigned)((R >> 1) * 2 * lda + (R & 1) * 32 + (C >> 5) * 64 + (C & 31)) * 2u : (unsigned)(R * lda + C) * 2u; vA[1][i] = vA[0][i] + (unsigned)(HALF * lda) * 2u; nvA[0][i] = vA[0][i]; nvA[1][i] = vA[1][i]; }
    const size_t kstep = (size_t)(BK * 2), kstepA = AIl<Epi>::v ? 2 * kstep : kstep;
    const size_t hstepB = (size_t)bh_rows_of<Epi>() * K * 2;
    const unsigned ldsw = (unsigned)wid * 1024u;
    const int aoff = lds_byte(wr * 64 + fr, fq * 8), boff = lds_byte(wc * 32 + fr, fq * 8);
#define PG8_SA(b, h) (((b) * 2 + (h)) * HTB)
#define PG8_SB(b, h) ((4 + (b) * 2 + (h)) * HTB)
#define PG8_STAGE2(bufoff, gbase, v0, v1) do { \
        __builtin_amdgcn_global_load_lds((const unsigned*)((const char*)(gbase) + (v0)), (LAS unsigned*)(lds + (bufoff) + ldsw), 16, 0, 0); \
        __builtin_amdgcn_global_load_lds((const unsigned*)((const char*)(gbase) + (v1)), (LAS unsigned*)(lds + (bufoff) + ldsw + 8192), 16, 0, 0); } while (0)
#define PG8_STAGEB(bufoff, gbase) PG8_STAGE2(bufoff, gbase, voffB[0], voffB[1])
#define PG8_LDA(dst, b, h) do { _Pragma("unroll") for (int m = 0; m < 4; ++m) _Pragma("unroll") for (int k = 0; k < 2; ++k) dst[m][k] = *(const LAS bf16x8*)(lds + PG8_SA(b, h) + aoff + m * 2048 + k * 1024); } while (0)
#define PG8_LDB(dst, b, h) do { _Pragma("unroll") for (int n = 0; n < 2; ++n) _Pragma("unroll") for (int k = 0; k < 2; ++k) dst[n][k] = *(const LAS bf16x8*)(lds + PG8_SB(b, h) + boff + n * 2048 + k * 1024); } while (0)
#define PG8_MMA(ai, bj, At, Bt) do { __builtin_amdgcn_s_setprio(1); _Pragma("unroll") for (int m = 0; m < 4; ++m) _Pragma("unroll") for (int n = 0; n < 2; ++n) _Pragma("unroll") for (int k = 0; k < 2; ++k) \
        acc[ai][bj][m][n] = __builtin_amdgcn_mfma_f32_16x16x32_bf16(Bt[n][k], At[m][k], acc[ai][bj][m][n], 0, 0, 0); __builtin_amdgcn_s_setprio(0); } while (0)
#define PG8_WAIT_V(n) asm volatile("s_waitcnt vmcnt(" #n ")" ::: "memory")
#define PG8_WAIT_L(n) asm volatile("s_waitcnt lgkmcnt(" #n ")" ::: "memory")
#define PG8_BAR __builtin_amdgcn_s_barrier()
#define PG8_SCHED __builtin_amdgcn_sched_barrier(0)
#define PG8_GATHER_OFFS(dst, U) do { _Pragma("unroll") for (int h = 0; h < 2; ++h) _Pragma("unroll") for (int i = 0; i < 2; ++i) { const int r_ = h * HALF + Rr[i]; \
        const int tok_ = *(const LAS int*)(lds + (U).rlds + r_ * 4); dst[h][i] = (unsigned)tok_ * (unsigned)(lda * 2) + (unsigned)Cb[i]; } } while (0)
    Unit cur, nxt; int ui = 0; int sig_rb = -1;
    if (!S.next(0, cur)) return;
    f32x4 acc[2][2][4][2];
#pragma unroll
    for (int a = 0; a < 2; ++a)
#pragma unroll
        for (int b = 0; b < 2; ++b)
#pragma unroll
            for (int m = 0; m < 4; ++m)
#pragma unroll
                for (int n = 0; n < 2; ++n) acc[a][b][m][n] = (f32x4){0.f, 0.f, 0.f, 0.f};
    bf16x8 At[4][2], B0[2][2], B1[2][2];
    const char* cA = cur.a; const char* cB = cur.b;
    if constexpr (GATHER) { PG8_GATHER_OFFS(vA, cur); }
    if constexpr ((Flow<Epi>::v & 2) != 0) S.wait_rows(cur);
    PG8_STAGEB(PG8_SB(0, 0), cB); PG8_STAGEB(PG8_SB(0, 1), cB + hstepB); PG8_STAGE2(PG8_SA(0, 0), cA, vA[0][0], vA[0][1]); PG8_STAGE2(PG8_SA(0, 1), cA, vA[1][0], vA[1][1]);
    if (wr == 1) PG8_BAR;
    PG8_WAIT_V(2); PG8_BAR;
    PG8_STAGEB(PG8_SB(1, 0), cB + kstep); PG8_STAGE2(PG8_SA(1, 0), cA + kstepA, vA[0][0], vA[0][1]); PG8_STAGEB(PG8_SB(1, 1), cB + hstepB + kstep);
    PG8_WAIT_V(6); PG8_BAR;
    for (;;) {
        const bool has_next = S.next(ui + 1, nxt);
        if constexpr ((Flow<Epi>::v & 2) != 0) { if (has_next) S.wait_rows(nxt); }
        const char* nA = has_next ? nxt.a : cA; const char* nB = has_next ? nxt.b : cB;
        if constexpr (GATHER) {
            if (has_next) { PG8_GATHER_OFFS(nvA, nxt); }
            else {
#pragma unroll
                for (int h = 0; h < 2; ++h)
#pragma unroll
                    for (int i = 0; i < 2; ++i) nvA[h][i] = vA[h][i]; }
        }
        const bool hf = Sched::HAS_HALF && (cur.half != 0 || cur.nvalid <= HALF);
        const bool sk0 = Sched::HAS_HALF && wr == 1 && cur.nvalid <= 64, sk1 = hf || (Sched::HAS_HALF && wr == 1 && cur.nvalid <= HALF + 64);
        for (int t = 0; t < nt; t += 2) {
            const bool last = (t == nt - 2);
            if constexpr (MIDK) { if (t == nt / 2) E.mid(acc, ui, wr, fr); }
            const char* a1 = cA + (size_t)(t + 1) * kstepA;
            const char* a2 = last ? nA : cA + (size_t)(t + 2) * kstepA; const char* b2 = last ? nB : cB + (size_t)(t + 2) * kstep;
            const char* a3 = a2 + kstepA; const char* b3 = b2 + kstep;
            unsigned x00 = vA[0][0], x01 = vA[0][1], x10 = vA[1][0], x11 = vA[1][1];
            if constexpr (GATHER) { if (last) { x00 = nvA[0][0]; x01 = nvA[0][1]; x10 = nvA[1][0]; x11 = nvA[1][1]; } }
            PG8_LDB(B0, 0, 0); PG8_LDB(B1, 0, 1); PG8_SCHED; if (!sk0) PG8_LDA(At, 0, 0); PG8_STAGE2(PG8_SA(1, 1), a1, vA[1][0], vA[1][1]);
            PG8_WAIT_V(8); PG8_WAIT_L(0); PG8_BAR; if (!sk0) { PG8_MMA(0, 0, At, B0); PG8_MMA(0, 1, At, B1); } PG8_BAR; PG8_SCHED;
            if (!sk1) PG8_LDA(At, 0, 1); PG8_STAGEB(PG8_SB(0, 0), b2); PG8_STAGEB(PG8_SB(0, 1), b2 + hstepB); PG8_STAGE2(PG8_SA(0, 0), a2, x00, x01);
            PG8_WAIT_V(8); PG8_WAIT_L(0); PG8_BAR; if (!sk1) { PG8_MMA(1, 0, At, B0); PG8_MMA(1, 1, At, B1); } PG8_BAR; PG8_SCHED;
            PG8_LDB(B0, 1, 0); PG8_LDB(B1, 1, 1); PG8_SCHED; if (!sk0) PG8_LDA(At, 1, 0); PG8_STAGE2(PG8_SA(0, 1), a2, x10, x11);
            PG8_WAIT_V(8); PG8_WAIT_L(0); PG8_BAR; if (!sk0) { PG8_MMA(0, 0, At, B0); PG8_MMA(0, 1, At, B1); } PG8_BAR; PG8_SCHED;
            if (!sk1) PG8_LDA(At, 1, 1); PG8_STAGEB(PG8_SB(1, 0), b3); PG8_STAGEB(PG8_SB(1, 1), b3 + hstepB); PG8_STAGE2(PG8_SA(1, 0), a3, x00, x01);
            PG8_WAIT_V(8); PG8_WAIT_L(0); PG8_BAR; if (!sk1) { PG8_MMA(1, 0, At, B0); PG8_MMA(1, 1, At, B1); } PG8_BAR; PG8_SCHED;
        }
        if (ALIGN_EPI) { if (wr == 0) PG8_BAR; }
        if constexpr ((Flow<Epi>::v & 1) != 0) { if (wid == 0 && sig_rb >= 0) S.signal_rb(sig_rb); }
        E(acc, cur, wr, wc, fr, fq);
        if constexpr ((Flow<Epi>::v & 1) != 0) sig_rb = cur.pm;
        if (!has_next) break;
#pragma unroll
        for (int a = 0; a < 2; ++a)
#pragma unroll
            for (int b = 0; b < 2; ++b)
#pragma unroll
                for (int m = 0; m < 4; ++m)
#pragma unroll
                    for (int n = 0; n < 2; ++n) acc[a][b][m][n] = (f32x4){0.f, 0.f, 0.f, 0.f};
        cur = nxt; cA = nA; cB = nB; ++ui;
#pragma unroll
        for (int h = 0; h < 2; ++h)
#pragma unroll
            for (int i = 0; i < 2; ++i) vA[h][i] = nvA[h][i];
        if (ALIGN_EPI) { if (wr == 1) PG8_BAR; }
    }
    PG8_WAIT_V(0);
    if (!ALIGN_EPI) { if (wr == 0) PG8_BAR; }
    PG8_BAR;
    if constexpr ((Flow<Epi>::v & 1) != 0) { if (wid == 0 && sig_rb >= 0) S.signal_rb(sig_rb); }
#undef PG8_SA
#undef PG8_SB
#undef PG8_STAGE2
#undef PG8_STAGEB
#undef PG8_LDA
#undef PG8_LDB
#undef PG8_MMA
#undef PG8_WAIT_V
#undef PG8_WAIT_L
#undef PG8_BAR
#undef PG8_SCHED
#undef PG8_GATHER_OFFS
}
}

namespace sb {
typedef float f32x16 __attribute__((ext_vector_type(16)));
typedef short s16x4 __attribute__((ext_vector_type(4)));
typedef float f32x2_t __attribute__((ext_vector_type(2)));
typedef __bf16 bf16x2_t __attribute__((ext_vector_type(2)));
constexpr int VPITCH = 128;
constexpr int VTILE_BYTES = 2 * 64 * VPITCH;
constexpr float EXIT2 = -66.0f;
__device__ __forceinline__ int crow(int r, int h) { return (r & 3) + 8 * (r >> 2) + 4 * h; }
__device__ __forceinline__ int krow(int s, int h, int j) { return 16 * s + 8 * (j >> 2) + 4 * h + (j & 3); }
__device__ __forceinline__ unsigned cvtpk(float lo, float hi) { f32x2_t v = {lo, hi}; bf16x2_t b = __builtin_convertvector(v, bf16x2_t); return __builtin_bit_cast(unsigned, b); }
#define SB_MFMA(a, b, c) __builtin_amdgcn_mfma_f32_32x32x16_bf16((a), (b), (c), 0, 0, 0)
template <int S> __device__ __forceinline__ bf16x8 pack8(const f32x16& x) {
    u32x4 p; p.x = cvtpk(x[8 * S + 0], x[8 * S + 1]); p.y = cvtpk(x[8 * S + 2], x[8 * S + 3]); p.z = cvtpk(x[8 * S + 4], x[8 * S + 5]); p.w = cvtpk(x[8 * S + 6], x[8 * S + 7]);
    return __builtin_bit_cast(bf16x8, p);
}
template <int S> __device__ __forceinline__ void pack8_hilo(const f32x16& x, bf16x8& hi, bf16x8& lo) {
    u32x4 ph, pl;
#pragma unroll
    for (int w = 0; w < 4; ++w) {
        const float a = x[8 * S + 2 * w], b = x[8 * S + 2 * w + 1];
        const unsigned h = cvtpk(a, b);
        const float ah = __builtin_bit_cast(float, h << 16), bh = __builtin_bit_cast(float, h & 0xffff0000u);
        ph[w] = h; pl[w] = cvtpk(a - ah, b - bh);
    }
    hi = __builtin_bit_cast(bf16x8, ph); lo = __builtin_bit_cast(bf16x8, pl);
}
__device__ __forceinline__ s16x4 vtr(LAS const unsigned char* p) { typedef short v4i16_t __attribute__((ext_vector_type(4))); return __builtin_bit_cast(s16x4, __builtin_amdgcn_ds_read_tr16_b64_v4i16((LAS v4i16_t*)p)); }

__device__ __forceinline__ float lo_half_bcast(float x) {
    const unsigned u = __builtin_bit_cast(unsigned, x);
    const auto r = __builtin_amdgcn_permlane32_swap(u, u, false, false);
    return __builtin_bit_cast(float, (unsigned)r[0]);
}
__device__ __forceinline__ float log2keep(float x) {
    const float t = __builtin_amdgcn_exp2f(-__builtin_fabsf(x));
    return __builtin_fmaf(-0.5f, x + __builtin_fabsf(x), -__builtin_amdgcn_logf(1.f + t));
}

__device__ __forceinline__ void glds16(const void* gsrc, unsigned lds_dst) { unsigned keep;
  asm volatile("s_mov_b32 %0, m0\n\ts_mov_b32 m0, %2\n\ts_nop 0\n\tglobal_load_lds_dwordx4 %1, off\n\ts_mov_b32 m0, %0" : "=&s"(keep) : "v"(gsrc), "s"(lds_dst) : "memory"); }
constexpr size_t VI_OFF = (WS_VI - WS_PROJ) / 2;
constexpr size_t QKI_OFF = (WS_QKI - WS_PROJ) / 2;
struct AttnPre { bf16x8 qf[8], nk0[4], nk1[4]; };
#define SB_LOAD_TILE_TO(NK0, NK1, TOK0, KV0, BUF) do { int lv_ = lane; asm volatile("" : "+v"(lv_)); \
        const char* kb_ = (const char*)(proj + QKI_OFF + ((size_t)(8 + h) * T + (TOK0) + (KV0)) * 64);     \
        const unsigned ko_ = (unsigned)((((lv_ & 31) >> 2) * 256 + (lv_ & 3) * 16 + 8 * (lv_ >> 5)) * 2); \
        _Pragma("unroll") for (int s = 0; s < 4; ++s) { NK0[s] = *(const bf16x8*)(kb_ + ko_ + 128 * s); NK1[s] = *(const bf16x8*)(kb_ + (ko_ + 4096u) + 128 * s); } \
        const bf16_t* vp_ = proj + VI_OFF + ((size_t)h * T + (TOK0) + (KV0)) * 64 + (lv_ >> 4) * 128 + ((lv_ & 7) >> 2) * 64 + ((lv_ >> 3) & 1) * 32 + (lv_ & 3) * 8;     \
        const unsigned vd_ = (unsigned)(size_t)(vlds) + (BUF) * 8192; \
        _Pragma("unroll") for (int it = 0; it < 8; ++it) glds16(vp_ + it * 512, vd_ + it * 1024); } while (0)
__device__ __forceinline__ void attn_issue(AttnPre& P, const bf16_t* proj, int b, int q0, int h, int lane, LAS unsigned char* vlds, int vbuf = 0) {
    const int tok0 = b * SEQ;
    { int lq = lane; asm volatile("" : "+v"(lq));
      const char* qb = (const char*)(proj + QKI_OFF + ((size_t)h * T + tok0 + q0) * 64);
      const unsigned qo = (unsigned)((((lq & 31) >> 2) * 256 + (lq & 3) * 16 + 8 * (lq >> 5)) * 2);
#pragma unroll
      for (int s = 0; s < 4; ++s) { P.qf[s] = __builtin_nontemporal_load((const bf16x8*)(qb + qo + 128 * s)); P.qf[4 + s] = __builtin_nontemporal_load((const bf16x8*)(qb + (qo + 4096u) + 128 * s)); } }
    SB_LOAD_TILE_TO(P.nk0, P.nk1, tok0, (q0 >> 6) * 64, vbuf);
}
__device__ __forceinline__ void attn_wave(AttnPre& P, const bf16_t* proj, int b, int q0, int h, int lane, LAS unsigned char* vlds, f32x16& oA0, f32x16& oA1, f32x16& oB0, f32x16& oB1, int ntq, int& vbuf  ) {
    const int r = lane & 31, hh = lane >> 5;
    const int tok0 = b * SEQ;
    bf16x8 (&qf)[8] = P.qf;
    bf16x8 triA[2];
#pragma unroll
    for (int j = 0; j < 8; ++j) { triA[0][j] = (krow(0, hh, j) >= r) ? (short)0x3F80 : (short)0; triA[1][j] = (krow(1, hh, j) >= r) ? (short)0x3F80 : (short)0; }
#pragma unroll
    for (int i = 0; i < 16; ++i) { oA0[i] = 0.f; oA1[i] = 0.f; oB0[i] = 0.f; oB1[i] = 0.f; }
    float carryA = 0.f, carryB = 0.f;
    bool doneA = false, doneB = false;
    const int jt0 = q0 >> 6;
    bf16x8 (&nk0)[4] = P.nk0; bf16x8 (&nk1)[4] = P.nk1;
#define SB_LOAD_TILE(KV0, BUF) SB_LOAD_TILE_TO(nk0, nk1, tok0, KV0, BUF)
    int buf = vbuf;
    for (int jt = jt0; jt >= 0; --jt) {
        const int kv0 = jt * 64;
        int lv = lane; asm volatile("" : "+v"(lv));
        asm volatile("s_waitcnt vmcnt(0)" ::: "memory");
        bf16x8 k0[4], k1[4];
#pragma unroll
        for (int s = 0; s < 4; ++s) { k0[s] = nk0[s]; k1[s] = nk1[s]; }
        LAS const unsigned char* vrd = vlds + buf * 8192 + (4 * (lv >> 5) + ((lv & 15) >> 2)) * VPITCH + (16 * ((lv >> 4) & 1) + 4 * (lv & 3)) * 2;
        buf ^= 1;
        const bool early = (jt == jt0) && (jt > 0);
        if (early) SB_LOAD_TILE(kv0 - 64, buf);
        const bool diag = (jt == jt0);
        const int dqA = q0 + (lv & 31) - kv0 - 4 * (lv >> 5), dqB = dqA + 32;
        const bool actA = !doneA, actB = !doneB;
        bool last = false;
#define SB_DECIDED(LAST) do { if (!(LAST)) { if (!early) SB_LOAD_TILE(kv0 - 64, buf); } \
        else if (ntq >= 0) { if (early) asm volatile("s_waitcnt vmcnt(0)" ::: "memory");     \
                             attn_issue(P, proj, ntq / SEQ, ntq % SEQ, h, lane, vlds, buf); vbuf = buf; } } while (0)
#define SB_VB(c, s, db) __builtin_shufflevector(vtr(vrd + (32 * (c) + 16 * (s)) * VPITCH + 64 * (db)), vtr(vrd + (32 * (c) + 16 * (s) + 8) * VPITCH + 64 * (db)), 0, 1, 2, 3, 4, 5, 6, 7)
#define SB_HALF(QO, OO0, OO1, CARRY, DONE, DQ, C, KC, HOOK) do { \
        f32x16 pp; _Pragma("unroll") for (int i = 0; i < 16; ++i) pp[i] = 0.f; \
        _Pragma("unroll") for (int s = 0; s < 4; ++s) pp = SB_MFMA(KC[s], qf[(QO) + s], pp); \
        bf16x8 xx[2]; \
        { f32x16 LL; _Pragma("unroll") for (int i = 0; i < 16; ++i) { float a = log2keep(pp[i]); if (diag) { const int ci = (i & 3) + 8 * (i >> 2) + 32 * (C); if (!(ci < (DQ))) a = 0.f; } LL[i] = a; } \
          xx[0] = pack8<0>(LL); xx[1] = pack8<1>(LL); } \
        float tot; \
        { f32x16 YY; _Pragma("unroll") for (int i = 0; i < 16; ++i) YY[i] = 0.f; \
          _Pragma("unroll") for (int s = 0; s < 2; ++s) YY = SB_MFMA(triA[s], xx[s], YY); \
          tot = lo_half_bcast(YY[0]);          \
          _Pragma("unroll") for (int i = 0; i < 16; ++i) pp[i] += YY[i]; } \
        const float ncarry = (CARRY) + tot; \
        const bool ex = __all(ncarry < EXIT2); \
        DONE = ex; \
        if (HOOK) { last = (doneA && doneB) || (jt == 0); SB_DECIDED(last); } \
        _Pragma("unroll") for (int i = 0; i < 16; ++i) { float a = __builtin_amdgcn_exp2f(pp[i] + (CARRY)); if (diag) { const int ci = (i & 3) + 8 * (i >> 2) + 32 * (C); if (!(ci < (DQ))) a = 0.f; } pp[i] = a; } \
        { const bf16x8 pa = pack8<0>(pp); OO0 = SB_MFMA(pa, SB_VB(C, 0, 0), OO0); OO1 = SB_MFMA(pa, SB_VB(C, 0, 1), OO1); } \
        { const bf16x8 pa = pack8<1>(pp); OO0 = SB_MFMA(pa, SB_VB(C, 1, 0), OO0); OO1 = SB_MFMA(pa, SB_VB(C, 1, 1), OO1); } \
        CARRY = ncarry; } while (0)
        if (actA) {
            if (!diag) SB_HALF(0, oA0, oA1, carryA, doneA, dqA, 1, k1, (ex && !actB));
            if (!doneA) SB_HALF(0, oA0, oA1, carryA, doneA, dqA, 0, k0, (!actB));
        }
        if (actB) {
            SB_HALF(4, oB0, oB1, carryB, doneB, dqB, 1, k1, (ex));
            if (!doneB) SB_HALF(4, oB0, oB1, carryB, doneB, dqB, 0, k0, (true));
        }
#undef SB_HALF
#undef SB_VB
#undef SB_DECIDED
        if (last) break;
    }
}
#undef SB_MFMA
#undef SB_LOAD_TILE
#undef SB_LOAD_TILE_TO
}

constexpr int I_IN = (D / 64) * (NPROJ / 32), I_OUT = (D / 64) * (D / 32), I_EXP = NE * 256, I_LAYER = I_IN + I_OUT + 3 * I_EXP;
struct CvtItem { const float* src; bf16_t* dst; int ldw, ldt; float scale; };
template <class PT> __device__ __forceinline__ CvtItem cvt_decode(const PT& p, int it, int lane) {
    const int l = it / I_LAYER; int r = it - l * I_LAYER;
    const float* W; bf16_t* WT; int ldw, ldt, k0, n0, drow0, kdst = -1; float scale = 1.f;
    if (r < I_IN) { const int kb = r / (NPROJ / 32), nb = r % (NPROJ / 32), blk = (32 * nb) >> 9, c = (32 * nb) & 511; n0 = 32 * nb; k0 = 64 * kb;
        drow0 = (blk == 0) ? c : (blk == 1) ? 1024 + (c >> 7) * 256 + (c & 127) : (blk == 2) ? 1024 + (c >> 7) * 256 + 128 + (c & 127) : (blk == 3) ? 512 + c : (blk == 4) ? 2048 + c : 2560 + c;
        W = p.w_in + (size_t)l * D * NPROJ; ldw = NPROJ; WT = (bf16_t*)(p.ws + WS_WIN) + (size_t)l * NPROJ * D; ldt = D; scale = blk == 3 ? QSCALE : 1.f; }
    else if (r < I_IN + I_OUT) { r -= I_IN; const int kb = r / (D / 32), nb = r % (D / 32); n0 = 32 * nb; k0 = 64 * kb;
        W = p.w_out + (size_t)l * D * D; ldw = D; WT = (bf16_t*)(p.ws + WS_WOUT) + (size_t)l * D * D; ldt = D; drow0 = n0; kdst = (k0 + 512) & 1023; }
    else { r -= I_IN + I_OUT; const int which = r / I_EXP; r -= which * I_EXP; const int e = r >> 8; r &= 255;
        if (which < 2) { const int kb = r >> 4, nb = r & 15; n0 = 32 * nb; k0 = 64 * kb;
            W = (which ? p.w_up : p.w_gate) + ((size_t)l * NE + e) * D * DEXP; ldw = DEXP; WT = (bf16_t*)(p.ws + WS_WGU) + ((size_t)l * NE + e) * 1024 * 1024; ldt = 1024; drow0 = (n0 >> 7) * 256 + (n0 & 127) + which * 128; }
        else { const int kb = r >> 5, nb = r & 31; n0 = 32 * nb; k0 = 64 * kb;
            W = p.w_down + ((size_t)l * NE + e) * DEXP * D; ldw = D; WT = (bf16_t*)(p.ws + WS_WD) + ((size_t)l * NE + e) * 1024 * 512; ldt = 512; drow0 = n0; } }
    CvtItem c; c.src = W + (size_t)(k0 + (lane >> 5)) * ldw + n0 + (lane & 31); c.dst = WT + (size_t)(drow0 + (lane >> 3)) * ldt + (kdst >= 0 ? kdst : k0) + 8 * (lane & 7); c.ldw = ldw; c.ldt = ldt; c.scale = scale; return c;
}
__device__ __forceinline__ void cvt_load(const CvtItem& c, float (&t)[32]) {
#pragma unroll
    for (int i = 0; i < 32; ++i) t[i] = __builtin_nontemporal_load(c.src + (size_t)(2 * i) * c.ldw);
}
__device__ __forceinline__ void cvt_store(const CvtItem& c, const float (&t)[32], LAS float* scr, int lane) {
#pragma unroll
    for (int i = 0; i < 32; ++i) scr[(2 * i + (lane >> 5)) * 33 + (lane & 31)] = t[i];
    LDS_WAIT(); asm volatile("" ::: "memory");
    const int cc = lane & 7; const float scale = c.scale;
#pragma unroll
    for (int j = 0; j < 4; ++j) { const int n = (lane >> 3) + 8 * j; const LAS float* s = scr + (8 * cc) * 33 + n;
        u32x4 o; o.x = pk2(s[0 * 33] * scale, s[1 * 33] * scale); o.y = pk2(s[2 * 33] * scale, s[3 * 33] * scale); o.z = pk2(s[4 * 33] * scale, s[5 * 33] * scale); o.w = pk2(s[6 * 33] * scale, s[7 * 33] * scale);
        *(u32x4*)(c.dst + (size_t)(8 * j) * c.ldt) = o; }
    LDS_WAIT(); asm volatile("" ::: "memory");
}
template <class PT> __device__ __forceinline__ void cvt_run(const PT& p, int it0, int it1, int step, LAS float* scr, int lane) {
    if (it0 >= it1) return;
    float ta[32], tb[32];
    CvtItem ca = cvt_decode(p, it0, lane), cb = ca;
    cvt_load(ca, ta);
    for (int it = it0; it < it1; it += 2 * step) {
        const bool hb = it + step < it1;
        if (hb) { cb = cvt_decode(p, it + step, lane); cvt_load(cb, tb); }
        cvt_store(ca, ta, scr, lane);
        if (!hb) break;
        const bool ha = it + 2 * step < it1;
        if (ha) { ca = cvt_decode(p, it + 2 * step, lane); cvt_load(ca, ta); }
        cvt_store(cb, tb, scr, lane);
    }
}
__device__ __forceinline__ void ln_finish_row(f32x4 (&v)[4], const float* g, const float* b, bf16_t* ob, float* of, int lane) {
    float s = 0.f;
#pragma unroll
    for (int j = 0; j < 4; ++j) s += (v[j].x + v[j].y) + (v[j].z + v[j].w);
    const float mean = wave_sum(s) * (1.f / D); float s2 = 0.f;
#pragma unroll
    for (int j = 0; j < 4; ++j) { v[j] = v[j] - mean; s2 += (v[j].x * v[j].x + v[j].y * v[j].y) + (v[j].z * v[j].z + v[j].w * v[j].w); }
    const float rstd = 1.f / sqrtf(wave_sum(s2) * (1.f / D) + LN_EPS);
#pragma unroll
    for (int j = 0; j < 4; ++j) {
        const int c = 4 * (64 * j + lane);
        v[j] = v[j] * rstd * *(const f32x4*)(g + c) + *(const f32x4*)(b + c);
        if (ob) { u32x2 w; w.x = pk2(v[j].x, v[j].y); w.y = pk2(v[j].z, v[j].w); *(u32x2*)(ob + c) = w; }
        if (of) *(f32x4*)(of + c) = v[j];
    }
}

struct MoeSched {
    static constexpr bool HAS_HALF = true;
    const LAS int* tabS; const LAS int* tabE; const LAS int* tabC; int G, vcu, npn, hv; bool down;
    unsigned* rdy;
    const char* A; const char* W; const int* list;
    __device__ __forceinline__ bool next(int i, pg8::Unit& u) const {
        const int total = __builtin_amdgcn_readfirstlane(tabS[NE]) * npn, nfr = total / G, R = total - nfr * G;
        int L, half = 0, second = 0;
        if (i < nfr) L = i * G + vcu;
        else if (i == nfr && hv < 2 * R) { L = nfr * G + (hv >> 1); half = 1; second = hv & 1; }
        else return false;
        const int rb = L / npn, pn = L % npn;
        const int e = __builtin_amdgcn_readfirstlane(tabE[rb]), lb = rb - __builtin_amdgcn_readfirstlane(tabS[e]), cnt = __builtin_amdgcn_readfirstlane(tabC[e]);
        int nv = cnt - lb * 256 - 128 * second; nv = nv < 0 ? 0 : nv; const int cap = half ? 128 : 256;
        { const int valid = cnt - lb * 256; u.need = 4 * ((rb * npn >= nfr * G && valid > 128) ? 2 : 1); }
        if (nv == 0) return false;
        u.pm = rb; u.pn = pn; u.row0 = rb * 256 + 128 * second; u.half = half; u.nvalid = nv < cap ? nv : cap; u.rl = list + (size_t)e * T + lb * 256 + 128 * second; u.rlds = TOKT_OFF + i * 1024;
        if (!down) { u.a = A; u.b = W + (size_t)e * (1024 * 1024 * 2) + (size_t)pn * (256 * 1024 * 2); }
        else { u.a = A + (size_t)(rb * 256 + 128 * second) * (DEXP * 2); u.b = W + (size_t)e * (1024 * 512 * 2) + (size_t)pn * (256 * 512 * 2); }
        return true;
    }
    __device__ __forceinline__ void signal_rb(int rb) const {
        if (lane_id_v() == 0) (void)xb_add(rdy + rb, 1u);
    }
    __device__ __forceinline__ void wait_rows(const pg8::Unit& u) const {
        unsigned sp = 0; const unsigned need = (unsigned)u.need;
        while ((unsigned)__builtin_amdgcn_readfirstlane((int)xb_ld(rdy + u.pm)) < need) { __builtin_amdgcn_s_sleep(1); if (++sp > XB_SPIN_CAP) break; }
        asm volatile("" ::: "memory");
    }
};


constexpr int XS_OFF = LDSCTL_OFF + 2048;
constexpr int RA_OFF = LDSCTL_OFF + 4096;
constexpr int GB_OFF = LDSCTL_OFF + 8192;
constexpr int LG16_OFF = LDSCTL_OFF + 16384;
constexpr int RT_OFF = LDSCTL_OFF + 4096;

__device__ __forceinline__ int fresh_lane() { return lane_id_v(); }
struct Args { Ptrs p; int ph_lo, ph_hi, li, pad; };

__device__ __forceinline__ void moe_tables(unsigned* ctl, int l, int wave_id, LAS int* tabS, LAS int* tabC, LAS int* tabE) {
    __syncthreads();
    const int tid = wave_id * 64 + fresh_lane();
    if (tid < 64) {
        const int e = tid & 31; const int c = (int)__hip_atomic_load(ctl + CW_CNT + 64 * l + e, RLX_AGENT); const int nb = (c + 255) >> 8;
        int incl = nb;
#pragma unroll
        for (int o = 1; o < 32; o <<= 1) { const int t = __shfl_up(incl, o, 32); if (e >= o) incl += t; }
        if (tid < 32) { tabS[e] = incl - nb; tabC[e] = c; if (e == 31) tabS[32] = incl; for (int rb = incl - nb; rb < incl; ++rb) tabE[rb] = e; }
    }
    __syncthreads();
}

__global__ void __launch_bounds__(NWAVES * 64, 2) mk_fwd(Args args) {
    extern __shared__ __attribute__((aligned(16))) unsigned char lds_raw[];
    LAS unsigned char* lds = (LAS unsigned char*)lds_raw;
    typedef const __attribute__((address_space(4))) Args KArgs;
    KArgs* const ka = (KArgs*)__builtin_amdgcn_kernarg_segment_ptr();
    const int tid0 = threadIdx.x; const int wave_s = __builtin_amdgcn_readfirstlane(tid0 >> 6);
    constexpr int G = 256;
    const int bx = blockIdx.x, vcu = (bx % 8) * (G / 8) + bx / 8;
    unsigned* ctl = (unsigned*)(args.p.ws + WS_CTL);
    for (int u = tid0; u < (LDS_BYTES - LDSCTL_OFF) / 4; u += NWAVES * 64) ((LAS unsigned*)(lds + LDSCTL_OFF))[u] = 0u;
    __syncthreads();
    volatile LAS unsigned* MISC = (volatile LAS unsigned*)(lds + MISC_OFF);
    XcdBarrier bar = xcd_barrier_post(ctl + CW_BAR + args.li * XCD_BAR_WORDS, MISC);
    if (bar.x != (unsigned)(bx & 7) && threadIdx.x == 0) (void)xb_add(ctl + CW_XMIS, 1u);
    LAS int* tabS = (LAS int*)(lds + TAB_OFF); LAS int* tabC = tabS + 40; LAS int* tabE = tabS + 80;
    constexpr int NGW = G * NWAVES;
    int tab_layer = -1;

    for (int ph = args.ph_lo; ph < args.ph_hi; ++ph) {
      const int nrep = 1 + ((PROBE_MASK >> (ph == 0 ? 0 : 1 + (ph - 1) % 7)) & 1);
      for (int rep = 0; rep < nrep; ++rep) {
        { const bool seam = PROBE_MASK == 0 && ph > 0 && ((ph - 1) % 7 == 5 || (ph - 1) % 7 == 2 || (ph - 1) % 7 == 3);
          if ((ph > args.ph_lo || rep > 0) && !(seam && MISC[2] == 0u)) xcd_barrier(bar, wave_s);
          if (ph == args.ph_lo + 1 && threadIdx.x == 0) MISC[2] = xb_ld(ctl + CW_XMIS); }
        KArgs* kp = ka; asm volatile("" : "+s"(kp));
#define p (kp->p)
        bf16_t* const PROJ = (bf16_t*)(p.ws + WS_PROJ);
        int lane_ = lane_id_v();
        const int lane = lane_, wave = wave_s, gw = vcu * NWAVES + wave;
#define tid (wave * 64 + fresh_lane())
        if (ph == 0) {
            LAS float* scr = (LAS float*)(lds + wave * 16384);
            if (vcu < 64) { const int idx = vcu * 512 + tid, k = idx >> 5, e = idx & 31; const float w = p.router_w[idx]; const unsigned hi = f2bf(w), lo = f2bf(w - bf2f(hi));
                const int off = e * D + ((((k >> 3) ^ (e & 15))) << 3) + (k & 7); unsigned short* im = (unsigned short*)(p.ws + WS_WRT); im[off] = (unsigned short)hi; im[NE * D + off] = (unsigned short)lo; }
            { int g0_ = gw; asm volatile("" : "+s"(g0_)); cvt_run(p, g0_, I_IN, NGW, scr, lane); }
            { f32x4 nv[4], gg[4], bb[4];
#pragma unroll
              for (int j = 0; j < 4; ++j) { gg[j] = *(const f32x4*)(p.ln0_g + 4 * (64 * j + lane)); bb[j] = *(const f32x4*)(p.ln0_b + 4 * (64 * j + lane)); }
              { const f32x4* xr = (const f32x4*)(p.x + (size_t)gw * D) + lane;
#pragma unroll
                for (int j = 0; j < 4; ++j) nv[j] = __builtin_nontemporal_load(xr + 64 * j); }
              for (int m = gw; m < T; m += NGW) {
                f32x4 v[4];
#pragma unroll
                for (int j = 0; j < 4; ++j) v[j] = nv[j];
                if (m + NGW < T) { const f32x4* xr = (const f32x4*)(p.x + (size_t)(m + NGW) * D) + lane;
#pragma unroll
                    for (int j = 0; j < 4; ++j) nv[j] = __builtin_nontemporal_load(xr + 64 * j); }
                float s1 = 0.f, s2 = 0.f;
#pragma unroll
                for (int j = 0; j < 4; ++j) { s1 += (v[j].x + v[j].y) + (v[j].z + v[j].w); s2 += (v[j].x * v[j].x + v[j].y * v[j].y) + (v[j].z * v[j].z + v[j].w * v[j].w); }
                s1 = wave_sum(s1); s2 = wave_sum(s2);
                const float mean = s1 * (1.f / D), rstd = 1.f / sqrtf(fmaxf(s2 * (1.f / D) - mean * mean, 0.f) + LN_EPS);
                bf16_t* hb = (bf16_t*)(p.ws + WS_HB) + (size_t)m * D;
#pragma unroll
                for (int j = 0; j < 4; ++j) {
                    const int c = 4 * (64 * j + lane);
                    const f32x4 o = (v[j] - mean) * rstd * gg[j] + bb[j];
                    u32x2 w; w.x = pk2(o.x, o.y); w.y = pk2(o.z, o.w); *(u32x2*)(hb + c) = w;
                }
              } }
            continue;
        }
        const int l = (ph - 1) / 7, sub = (ph - 1) % 7;
        if (sub == 0) {
            pg8::StaticOrder S; S.init(p.ws + WS_HB, D, (bf16_t*)(p.ws + WS_WIN) + (size_t)l * NPROJ * D, T, NPROJ, D, G, bx);
            pg8::EpiInProj E{PROJ, PP, (bf16_t*)(p.ws + WS_QKI), (bf16_t*)(p.ws + WS_VI)};
            const int gsplit = (l == 0) ? (vcu % 7) : 0;
            for (int part = 0; part < 2; ++part) {
                S.r0 = part ? gsplit : 0; S.r1 = part ? (1 << 30) : gsplit;
                if (S.r0 < S.r1) pg8::gemm_phase<pg8::EpiInProj, pg8::StaticOrder, false>(lds, wave, D, D, S, E);
                if (part == 0 && l == 0 && !(nrep == 2 && rep == 1)) {
                    LAS float* scr = (LAS float*)(lds + wave * 16384);
                    { constexpr int CH = (DEPTH * I_LAYER - I_IN + G - 1) / G;
                      int g0_ = I_IN + vcu * CH + wave; asm volatile("" : "+s"(g0_)); const int e_ = I_IN + (vcu + 1) * CH; cvt_run(p, g0_, e_ < DEPTH * I_LAYER ? e_ : DEPTH * I_LAYER, NWAVES, scr, fresh_lane()); }
                    LDS_WAIT(); __syncthreads();
                }
            }
        } else if (sub == 1) {
            const int h = wave;
            const bool dry = (nrep == 2 && rep == 0);
            const bool do_attn = !dry, do_conv = !dry || (PROBE_MASK & 0x200);
            sb::AttnPre pre;
#pragma unroll
            for (int s = 0; s < 4; ++s) { pre.qf[s] = (bf16x8){0, 0, 0, 0, 0, 0, 0, 0}; pre.qf[4 + s] = pre.qf[s]; pre.nk0[s] = pre.qf[s]; pre.nk1[s] = pre.qf[s]; }
            int vbuf0 = 0;
            { const int r_ = lane & 31;
              pg8::f32x2_e gq_; gq_.x = p.g_attn[l * DA + h * HD + r_]; gq_.y = p.g_attn[l * DA + h * HD + 32 + r_]; *(LAS pg8::f32x2_e*)(lds + LDSCTL_OFF + 8192 + wave * 1024 + 8 * lane) = gq_; }
            constexpr int NUNIT = NBATCH * (SEQ / 64);
            if (do_attn && vcu < NUNIT) sb::attn_issue(pre, PROJ, vcu / (SEQ / 64), (vcu % (SEQ / 64)) * 64, h, lane, lds + wave * sb::VTILE_BYTES);
            for (int i = 0; do_attn; ++i) {
                const int u = i * G + vcu; if (u >= NUNIT) break;
                const int b = u / (SEQ / 64), q0 = (u % (SEQ / 64)) * 64;
                sb::f32x16 oA0, oA1, oB0, oB1;
                { const int un_ = u + G; const bool hn_ = un_ < NUNIT;
                  sb::attn_wave(pre, PROJ, b, q0, h, lane, lds + wave * sb::VTILE_BYTES, oA0, oA1, oB0, oB1, hn_ ? un_ * 64 : -1, vbuf0); }
#define ATT_EPI(o0, o1, QR0) do { \
                int le = lane; asm volatile("" : "+v"(le));                         \
                const int r = le & 31, hh = le >> 5; \
                { float ss[16], a8[8], a4[4], a2[2], a1;                            \
                  _Pragma("unroll") for (int k = 0; k < 16; ++k) ss[k] = o0[k] * o0[k] + o1[k] * o1[k]; \
                  { const bool up = (r & 16) != 0; \
                    _Pragma("unroll") for (int k = 0; k < 8; ++k) { const float mine = up ? ss[k + 8] : ss[k], oth = up ? ss[k] : ss[k + 8]; a8[k] = mine + __shfl_xor(oth, 16); } } \
                  { const bool up = (r & 8) != 0; \
                    _Pragma("unroll") for (int k = 0; k < 4; ++k) { const float mine = up ? a8[k + 4] : a8[k], oth = up ? a8[k] : a8[k + 4]; a4[k] = mine + __shfl_xor(oth, 8); } } \
                  { const bool up = (r & 4) != 0; \
                    _Pragma("unroll") for (int k = 0; k < 2; ++k) { const float mine = up ? a4[k + 2] : a4[k], oth = up ? a4[k] : a4[k + 2]; a2[k] = mine + __shfl_xor(oth, 4); } } \
                  { const bool up = (r & 2) != 0; const float mine = up ? a2[1] : a2[0], oth = up ? a2[0] : a2[1]; a1 = mine + __shfl_xor(oth, 2); } \
                  a1 += __shfl_xor(a1, 1); \
                  const int k = r >> 1;                                             \
                  if ((r & 1) == 0) ((float*)(p.ws + WS_SSQ))[(size_t)(b * SEQ + (QR0) + sb::crow(k, hh)) * 8 + h] = a1; } \
                const pg8::f32x2_e gq_ = *(LAS const pg8::f32x2_e*)(lds + LDSCTL_OFF + 8192 + wave * 1024 + 8 * le); const float g0 = gq_.x, g1 = gq_.y; \
                  \
                { LAS unsigned char* vst = lds + wave * sb::VTILE_BYTES + (vbuf0 ^ 1) * 8192; \
                  _Pragma("unroll") for (int k = 0; k < 16; ++k) { LAS unsigned short* wp = (LAS unsigned short*)(vst + sb::crow(k, hh) * 144) + r; const unsigned pk = pk2(o0[k] * g0, o1[k] * g1); wp[0] = (unsigned short)pk; wp[32] = (unsigned short)(pk >> 16); } \
                  LDS_WAIT(); asm volatile("" ::: "memory"); \
                  bf16_t* op = PROJ + (size_t)(b * SEQ + (QR0) + (le >> 3)) * PP + PO_Q + h * HD + 8 * (le & 7); \
                  _Pragma("unroll") for (int j = 0; j < 4; j += 2) { \
                      const u32x4 ova = *(LAS const u32x4*)(vst + ((le >> 3) + 8 * j) * 144 + (le & 7) * 16), ovb = *(LAS const u32x4*)(vst + ((le >> 3) + 8 * j + 8) * 144 + (le & 7) * 16); \
                      *(u32x4*)(op + (size_t)(8 * j) * PP) = ova; *(u32x4*)(op + (size_t)(8 * j + 8) * PP) = ovb; \
                      __builtin_amdgcn_sched_barrier(0); } \
                  LDS_WAIT(); asm volatile("" ::: "memory"); } } while (0)
                ATT_EPI(oA0, oA1, q0);
                ATT_EPI(oB0, oB1, q0 + 32);
#undef ATT_EPI
            }
            if (do_conv) {
                constexpr int RPW = T / NGW; static_assert(RPW == 16 && NUNIT == 2 * G, "conv rows = attention rows");
                const int m0 = ((wave & 4) ? vcu + G : vcu) * 64 + (wave & 3) * RPW, tpos0 = m0 % SEQ;
                const float* cwp = p.conv_w + (size_t)l * 3 * DC + 8 * lane; const float* gp = p.g_conv + l * DC + 8 * lane;
                float w0c[8], w1c[8], w2c[8], gc[8];
#pragma unroll
                for (int j = 0; j < 8; ++j) { w0c[j] = cwp[j]; w1c[j] = cwp[DC + j]; w2c[j] = cwp[2 * DC + j]; gc[j] = gp[j]; }
                float u1[8], u2[8];
                { const bf16_t* pr = PROJ + (size_t)m0 * PP + 8 * lane; const u32x4 z4 = (u32x4){0u, 0u, 0u, 0u};
                  unpack8(tpos0 >= 1 ? *(const u32x4*)(pr - PP + PO_U) : z4, u1); unpack8(tpos0 >= 2 ? *(const u32x4*)(pr - 2 * PP + PO_U) : z4, u2); }
                u32x4 nq[4][2];
#pragma unroll
                for (int d = 0; d < 4; ++d) { const bf16_t* pr = PROJ + (size_t)(m0 + (d < RPW ? d : 0)) * PP + 8 * lane; nq[d][0] = __builtin_nontemporal_load((const u32x4*)(pr + PO_B)); nq[d][1] = __builtin_nontemporal_load((const u32x4*)(pr + PO_U)); }
                static_assert(RPW % 4 == 0, "conv ring");
#define CONV_ROW(d) { const int mm = m0 + i + d; bf16_t* pr = PROJ + (size_t)mm * PP + 8 * lane; float cb[8], u0[8]; asm volatile("" : "+v"(nq[d][0]), "+v"(nq[d][1]) :: "memory");     \
                    unpack8(nq[d][0], cb); unpack8(nq[d][1], u0); \
                    if (i + d + 4 < RPW) { const bf16_t* pn_ = pr + 4 * PP; nq[d][0] = __builtin_nontemporal_load((const u32x4*)(pn_ + PO_B)); nq[d][1] = __builtin_nontemporal_load((const u32x4*)(pn_ + PO_U)); }     \
                    float co[8], ss = 0.f; \
                    _Pragma("unroll") for (int j = 0; j < 8; ++j) { co[j] = cb[j] * (w0c[j] * u2[j] + w1c[j] * u1[j] + w2c[j] * u0[j]); ss += co[j] * co[j]; u2[j] = u1[j]; u1[j] = u0[j]; } \
                    const float rr = 1.f / sqrtf(wave_sum(ss) * (1.f / DC) + RMS_EPS); \
                    u32x4 w; w.x = pk2(co[0] * rr * gc[0], co[1] * rr * gc[1]); w.y = pk2(co[2] * rr * gc[2], co[3] * rr * gc[3]); w.z = pk2(co[4] * rr * gc[4], co[5] * rr * gc[5]); w.w = pk2(co[6] * rr * gc[6], co[7] * rr * gc[7]); \
                    if (dry) *(u32x4*)((bf16_t*)(p.ws + WS_H1B) + (size_t)mm * D + 512 + 8 * lane) = w; else *(u32x4*)(pr + PO_B) = w; }
#pragma unroll
                for (int i = 0; i < RPW; i += 4) { CONV_ROW(0) CONV_ROW(1) CONV_ROW(2) CONV_ROW(3) }
#undef CONV_ROW
            }
            VM_WAIT(); __syncthreads();
            if (wave == 0 && lane_id_v() == 0) {
                (void)xb_add(ctl + CW_RDYA + 256 * l + (vcu >> 2), 1u); (void)xb_add(ctl + CW_RDYA + 256 * l + (vcu >> 2) + G / 4, 1u); }
        } else if (sub == 2) {
            pg8::WoutOrder S; S.nwg = (T / 256) * (D / 256); S.G = G; S.c = vcu; S.A = (const char*)(p.ws + WS_PROJ); S.Bt = (const char*)((bf16_t*)(p.ws + WS_WOUT) + (size_t)l * D * D);
            S.astep = (size_t)256 * PP * 2; S.bstep = (size_t)256 * D * 2; S.rdy = ctl + CW_RDYA + 256 * l;
            { pg8::Unit u0{}, u1{}; const bool h0 = S.next(0, u0), h1 = S.next(1, u1); unsigned sp = 0;
              if (wave == 0) for (;;) { const unsigned a = h0 ? xb_ld(S.rdy + u0.pm) : 4u, b = h1 ? xb_ld(S.rdy + u1.pm) : 4u;
                  if (__builtin_amdgcn_readfirstlane((int)(a < b ? a : b)) >= 4 || ++sp > XB_SPIN_CAP) break; __builtin_amdgcn_s_sleep(8); }
              asm volatile("" ::: "memory"); __syncthreads(); }
            LAS float* ra = (LAS float*)(lds + RA_OFF);
            { const int t_ = tid, uo = t_ >> 8; pg8::Unit uu{};
              if (S.next(uo, uu)) { const f32x4* sq = (const f32x4*)((const float*)(p.ws + WS_SSQ) + (size_t)(uu.row0 + (t_ & 255)) * 8); const f32x4 a = sq[0], c = sq[1];
                  ra[t_] = 1.f / sqrtf((((a.x + a.y) + (a.z + a.w)) + ((c.x + c.y) + (c.z + c.w))) * (1.f / DA) + RMS_EPS); } }
            __syncthreads();
            pg8::EpiResBf16 E{(const bf16_t*)(p.ws + WS_HB), (bf16_t*)p.out, D, ALPHA, (float*)(p.ws + WS_STATP), ra};
            pg8::gemm_phase<pg8::EpiResBf16, pg8::WoutOrder, false, PG8_ALIGN, true>(lds, wave, D, PP, S, E);
        } else if (sub == 3) {
            LAS unsigned short* wh = (LAS unsigned short*)lds; LAS unsigned short* wlo = wh + NE * D;
            { u32x4 t[16];
#pragma unroll
              for (int i = 0; i < 16; ++i) t[i] = *(const u32x4*)(p.ws + WS_WRT + (size_t)(i * NWAVES * 64 + tid) * 16);
#pragma unroll
              for (int i = 0; i < 16; ++i) *(LAS u32x4*)(lds + (i * NWAVES * 64 + tid) * 16) = t[i]; }
            LAS float* gbl = (LAS float*)(lds + GB_OFF);
            if (tid < 256) *(LAS f32x4*)(gbl + 4 * tid) = *(const f32x4*)(p.ln_mix_g + l * D + 4 * tid); else *(LAS f32x4*)(gbl + D + 4 * (tid - 256)) = *(const f32x4*)(p.ln_mix_b + l * D + 4 * (tid - 256));
            LAS int* lcnt = (LAS int*)(lds + RT_OFF); LAS int* gbase = lcnt + 32; LAS unsigned* rinfo = (LAS unsigned*)(lds + RT_OFF + 256);
            LAS float* rbs = (LAS float*)(lds + RT_OFF + 3584);
            if (tid < 32) { lcnt[tid] = 0; rbs[tid] = p.router_b[tid]; }
            __syncthreads();
            const bool dryr = (nrep == 2 && rep == 0);
            int li = 0;
            static_assert(T / 16 == NGW, "one 16-row tile per wave");
            const int tile0 = ((wave & 4) ? vcu + G : vcu) * 4 + (wave & 3);
            { unsigned sp = 0; unsigned* rw = ctl + CW_RDYW + 256 * l + (tile0 >> 4);
              while ((unsigned)__builtin_amdgcn_readfirstlane((int)xb_ld(rw)) < 4u) { __builtin_amdgcn_s_sleep(16); if (++sp > XB_SPIN_CAP) break; }
              asm volatile("" ::: "memory"); }
            for (int tile = tile0; tile < T / 16 && li < 1; ++li) {
                const int c16 = lane & 15, kq = lane >> 4, mrow = 16 * tile + c16;
                float mean, rstd;
                { const pg8::f32x2_e* pp = (const pg8::f32x2_e*)(p.ws + WS_STATP) + mrow; float s1 = 0.f, s2 = 0.f;
#pragma unroll
                  for (int j = 0; j < 8; ++j) { const pg8::f32x2_e ta = pp[(size_t)(2 * j) * T], tb = pp[(size_t)(2 * j + 1) * T]; s1 += ta.x + tb.x; s2 += ta.y + tb.y; }
                  mean = s1 * (1.f / D); rstd = 1.f / sqrtf(fmaxf(s2 * (1.f / D) - mean * mean, 0.f) + LN_EPS); }
                const bf16_t* vrow = (const bf16_t*)p.out + (size_t)(mrow >> 1) * (2 * D) + (mrow & 1) * 32 + 8 * kq;
                bf16_t* hrow = (bf16_t*)(p.ws + WS_H1B) + (size_t)mrow * D + 8 * kq;
                LAS const unsigned char* whb = (LAS const unsigned char*)wh; LAS const unsigned char* wlb = (LAS const unsigned char*)wlo;
                f32x4 acc0 = (f32x4){0.f, 0.f, 0.f, 0.f}, acc1 = acc0;
                u32x4 pq[8];
#pragma unroll
                for (int d = 0; d < 8; ++d) pq[d] = __builtin_nontemporal_load((const u32x4*)(vrow + 64 * d));
#pragma unroll
                for (int s = 0; s < 32; ++s) {
                    const u32x4 rv = pq[s & 7];
                    if (s + 8 < 32) pq[s & 7] = __builtin_nontemporal_load((const u32x4*)(vrow + 64 * (s + 8)));
                    const f32x4 v0 = (f32x4){bf2f(rv.x & 0xffffu), bf2f(rv.x >> 16), bf2f(rv.y & 0xffffu), bf2f(rv.y >> 16)}, v1 = (f32x4){bf2f(rv.z & 0xffffu), bf2f(rv.z >> 16), bf2f(rv.w & 0xffffu), bf2f(rv.w >> 16)};
                    const f32x4 g0 = *(const LAS f32x4*)(gbl + 32 * s + 8 * kq), g1 = *(const LAS f32x4*)(gbl + 32 * s + 8 * kq + 4);
                    const f32x4 b0 = *(const LAS f32x4*)(gbl + D + 32 * s + 8 * kq), b1 = *(const LAS f32x4*)(gbl + D + 32 * s + 8 * kq + 4);
                    const f32x4 h0 = (v0 - mean) * rstd * g0 + b0, h1 = (v1 - mean) * rstd * g1 + b1;
                    u32x4 ah, al;
                    ah.x = sb::cvtpk(h0.x, h0.y); ah.y = sb::cvtpk(h0.z, h0.w); ah.z = sb::cvtpk(h1.x, h1.y); ah.w = sb::cvtpk(h1.z, h1.w);
                    al.x = sb::cvtpk(h0.x - __builtin_bit_cast(float, ah.x << 16), h0.y - __builtin_bit_cast(float, ah.x & 0xffff0000u));
                    al.y = sb::cvtpk(h0.z - __builtin_bit_cast(float, ah.y << 16), h0.w - __builtin_bit_cast(float, ah.y & 0xffff0000u));
                    al.z = sb::cvtpk(h1.x - __builtin_bit_cast(float, ah.z << 16), h1.y - __builtin_bit_cast(float, ah.z & 0xffff0000u));
                    al.w = sb::cvtpk(h1.z - __builtin_bit_cast(float, ah.w << 16), h1.w - __builtin_bit_cast(float, ah.w & 0xffff0000u));
                    *(u32x4*)(hrow + 32 * s) = ah;
                    const int boff = c16 * (D * 2) + (((4 * s + kq) ^ c16) << 4);
                    const bf16x8 bh0 = *(const LAS bf16x8*)(whb + boff), bh1 = *(const LAS bf16x8*)(whb + boff + 16 * D * 2);
                    const bf16x8 bl0 = *(const LAS bf16x8*)(wlb + boff), bl1 = *(const LAS bf16x8*)(wlb + boff + 16 * D * 2);
                    const bf16x8 ahv = __builtin_bit_cast(bf16x8, ah), alv = __builtin_bit_cast(bf16x8, al);
                    acc0 = __builtin_amdgcn_mfma_f32_16x16x32_bf16(ahv, bh0, acc0, 0, 0, 0); acc1 = __builtin_amdgcn_mfma_f32_16x16x32_bf16(ahv, bh1, acc1, 0, 0, 0);
                    acc0 = __builtin_amdgcn_mfma_f32_16x16x32_bf16(ahv, bl0, acc0, 0, 0, 0); acc1 = __builtin_amdgcn_mfma_f32_16x16x32_bf16(ahv, bl1, acc1, 0, 0, 0);
                    acc0 = __builtin_amdgcn_mfma_f32_16x16x32_bf16(alv, bh0, acc0, 0, 0, 0); acc1 = __builtin_amdgcn_mfma_f32_16x16x32_bf16(alv, bh1, acc1, 0, 0, 0);
                }
                LAS float* lg = (LAS float*)(lds + LG16_OFF) + wave * 512;
#pragma unroll
                for (int i = 0; i < 4; ++i) { lg[(4 * kq + i) * 32 + c16] = acc0[i]; lg[(4 * kq + i) * 32 + 16 + c16] = acc1[i]; }
                if (lane < 16) {
                    const LAS float* L = lg + lane * 32;
                    float sc[32], sel[32];
#pragma unroll
                    for (int e = 0; e < 32; ++e) { sc[e] = 1.f / (1.f + __expf(-L[e])); sel[e] = sc[e] + rbs[e]; }
                    int g = 0; float best = -3.0e38f;
#pragma unroll
                    for (int j = 0; j < 8; ++j) {
                        const float s0 = sel[4 * j], s1_ = sel[4 * j + 1], s2_ = sel[4 * j + 2], s3 = sel[4 * j + 3];
                        const float gs = fmaxf(fmaxf(fmaxf(s0 + s1_, s0 + s2_), fmaxf(s0 + s3, s1_ + s2_)), fmaxf(s1_ + s3, s2_ + s3));
                        if (gs > best) { best = gs; g = j; }
                    }
                    float uu[4], ss[4];
#pragma unroll
                    for (int k = 0; k < 4; ++k) { uu[k] = sel[k]; ss[k] = sc[k]; }
#pragma unroll
                    for (int j = 1; j < 8; ++j) if (g == j) {
#pragma unroll
                        for (int k = 0; k < 4; ++k) { uu[k] = sel[4 * j + k]; ss[k] = sc[4 * j + k]; } }
                    int i0 = 0; float b0 = uu[0], w0r = ss[0];
#pragma unroll
                    for (int k = 1; k < 4; ++k) if (uu[k] > b0) { b0 = uu[k]; i0 = k; w0r = ss[k]; }
                    int i1 = -1; float b1 = -3.0e38f, w1r = 0.f;
#pragma unroll
                    for (int k = 0; k < 4; ++k) if (k != i0 && uu[k] > b1) { b1 = uu[k]; i1 = k; w1r = ss[k]; }
                    const float inv = 1.f / (w0r + w1r);
                    if (!dryr) {
                        const int e0 = 4 * g + i0, e1 = 4 * g + i1;
                        const int lp0 = __hip_atomic_fetch_add(&lcnt[e0], 1, __ATOMIC_RELAXED, __HIP_MEMORY_SCOPE_WORKGROUP), lp1 = __hip_atomic_fetch_add(&lcnt[e1], 1, __ATOMIC_RELAXED, __HIP_MEMORY_SCOPE_WORKGROUP);
                        LAS unsigned* ri = rinfo + ((li * NWAVES + wave) * 16 + lane) * 6;
                        ri[0] = (unsigned)e0; ri[1] = (unsigned)e1; ri[2] = (unsigned)lp0; ri[3] = (unsigned)lp1; ri[4] = __builtin_bit_cast(unsigned, w0r * inv); ri[5] = __builtin_bit_cast(unsigned, w1r * inv);
                    }
                }
            }
            __syncthreads();
            {
            if (tid < 32) gbase[tid] = (int)atomicAdd(&ctl[CW_CNT + 64 * l + tid], (unsigned)lcnt[tid]);
            __syncthreads();
            if (tid < li * NWAVES * 16 && !(nrep == 2 && rep == 0)) {
                const int w_ = (tid >> 4) & 7, row = 16 * (((w_ & 4) ? vcu + G : vcu) * 4 + (w_ & 3)) + (tid & 15);
                const LAS unsigned* ri = rinfo + tid * 6;
                const int e0 = (int)ri[0], e1 = (int)ri[1]; const unsigned p0 = (unsigned)gbase[e0] + ri[2], p1 = (unsigned)gbase[e1] + ri[3];
                int* list = (int*)(p.ws + WS_LIST);
                list[(size_t)e0 * T + p0] = row; list[(size_t)e1 * T + p1] = row;
                u32x4 a; a.x = (unsigned)e0; a.y = (unsigned)e1; a.z = p0; a.w = p1;
                unsigned* rt = (unsigned*)(p.ws + WS_ROUTE) + (size_t)row * 8;
                *(u32x4*)rt = a; rt[4] = ri[4]; rt[5] = ri[5];
            } }
            __syncthreads();
        } else if (sub == 4 || sub == 5) {
            if (tab_layer != l) { moe_tables(ctl, l, wave, tabS, tabC, tabE); tab_layer = l; }
            MoeSched S; S.rdy = ctl + CW_RDY + 512 * l; S.tabS = tabS; S.tabE = tabE; S.tabC = tabC; S.G = G; S.vcu = vcu; S.npn = 4;
            { const int total = __builtin_amdgcn_readfirstlane(tabS[NE]) * 4, R = total % G; S.hv = vcu;
              if (4 * R <= G) S.hv = (((vcu >> 4) & 1) == (sub == 5 ? 1 : 0)) ? (vcu >> 5) * 16 + (vcu & 15) : (1 << 20); } S.list = (const int*)(p.ws + WS_LIST);
            if (sub == 4) {
                S.down = false; S.A = (const char*)(p.ws + WS_H1B); S.W = (const char*)(p.ws + WS_WGU) + (size_t)l * NE * 1024 * 1024 * 2;
                pg8::EpiSiluMul E{(bf16_t*)(p.ws + WS_HID), DEXP};
                { pg8::Unit uu{}; const int t_ = tid;
                  for (int i = 0; i < 8 && S.next(i, uu); ++i) if (t_ < 256) *(LAS int*)(lds + TOKT_OFF + i * 1024 + t_ * 4) = uu.rl[t_ < uu.nvalid ? t_ : 0]; }
                __syncthreads();
                pg8::gemm_phase<pg8::EpiSiluMul, MoeSched, true>(lds, wave, D, D, S, E);
            } else {
                S.down = true; S.A = (const char*)(p.ws + WS_HID); S.W = (const char*)(p.ws + WS_WD) + (size_t)l * NE * 1024 * 512 * 2;
                pg8::EpiStoreFp8 E{p.ws + WS_Y, D, Y_SCALE};
                pg8::gemm_phase<pg8::EpiStoreFp8, MoeSched, false>(lds, wave, DEXP, DEXP, S, E);
            }
        } else {
            if (tab_layer != l) { moe_tables(ctl, l, wave, tabS, tabC, tabE); tab_layer = l; }
            const int nrows = (T - gw + NGW - 1) / NGW;
            f32x4 gg[4], bb[4];
#pragma unroll
            for (int j = 0; j < 4; ++j) { const int c = 512 * (j >> 1) + 8 * lane + 4 * (j & 1); gg[j] = *(const f32x4*)(p.ln_ffn_g + l * D + c); bb[j] = *(const f32x4*)(p.ln_ffn_b + l * D + c); }
            const bool lastl = (l == DEPTH - 1);
            u32x4 ri_a, ri_b; unsigned wa0, wa1, wb0, wb1;
            u32x4 da[4], db[4]; float fa0, fa1, fb0, fb1;
#define CMB_ROUTE(RI, W0, W1, mm) do { const unsigned* rt_ = (const unsigned*)(p.ws + WS_ROUTE) + (size_t)(mm) * 8; RI = *(const u32x4*)rt_; W0 = rt_[4]; W1 = rt_[5]; } while (0)
#define CMB_DATA(DD, RI, mm) do { const unsigned char* y0_ = p.ws + WS_Y + (size_t)(tabS[RI.x] * 256 + (int)RI.z) * D + 8 * lane; \
                const unsigned char* y1_ = p.ws + WS_Y + (size_t)(tabS[RI.y] * 256 + (int)RI.w) * D + 8 * lane; const bf16_t* h1_ = (const bf16_t*)(p.ws + WS_H1B) + (size_t)(mm) * D + 8 * lane; \
                DD[0] = __builtin_nontemporal_load((const u32x4*)(h1_)); DD[1] = __builtin_nontemporal_load((const u32x4*)(h1_ + 512)); const u32x2 ya_ = __builtin_nontemporal_load((const u32x2*)(y0_)), yb_ = __builtin_nontemporal_load((const u32x2*)(y0_ + 512)), yc_ = __builtin_nontemporal_load((const u32x2*)(y1_)), yd_ = __builtin_nontemporal_load((const u32x2*)(y1_ + 512)); \
                DD[2] = (u32x4){ya_.x, ya_.y, yb_.x, yb_.y}; DD[3] = (u32x4){yc_.x, yc_.y, yd_.x, yd_.y}; } while (0)
            { u32x4 r0; unsigned w0_, w1_;
              CMB_ROUTE(r0, w0_, w1_, gw); fa0 = __builtin_bit_cast(float, w0_); fa1 = __builtin_bit_cast(float, w1_); CMB_DATA(da, r0, gw);
              if (nrows > 1) { CMB_ROUTE(r0, w0_, w1_, gw + NGW); fb0 = __builtin_bit_cast(float, w0_); fb1 = __builtin_bit_cast(float, w1_); CMB_DATA(db, r0, gw + NGW); } else { fb0 = fb1 = 0.f;
#pragma unroll
                  for (int j = 0; j < 4; ++j) db[j] = da[j]; }
              if (nrows > 2) CMB_ROUTE(ri_a, wa0, wa1, gw + 2 * NGW); else { ri_a = r0; wa0 = wa1 = 0u; }
              if (nrows > 3) CMB_ROUTE(ri_b, wb0, wb1, gw + 3 * NGW); else { ri_b = r0; wb0 = wb1 = 0u; } }
            for (int i = 0; i < nrows; ++i) {
                const int m = gw + i * NGW;
                u32x4 d[4];
#pragma unroll
                for (int j = 0; j < 4; ++j) { d[j] = da[j]; da[j] = db[j]; }
                const float w0 = fa0 * (1.f / Y_SCALE), w1 = fa1 * (1.f / Y_SCALE); fa0 = fb0; fa1 = fb1;
                if (i + 2 < nrows) { fb0 = __builtin_bit_cast(float, wa0); fb1 = __builtin_bit_cast(float, wa1); CMB_DATA(db, ri_a, m + 2 * NGW); }
                ri_a = ri_b; wa0 = wb0; wa1 = wb1;
                if (i + 4 < nrows) CMB_ROUTE(ri_b, wb0, wb1, m + 4 * NGW);
                f32x4 v[4]; float s1 = 0.f, s2 = 0.f;
#pragma unroll
                for (int j = 0; j < 4; ++j) {
                    const int pc = j >> 1, hq = j & 1;
                    const unsigned h_lo = hq ? d[pc].z : d[pc].x, h_hi = hq ? d[pc].w : d[pc].y;
                    const unsigned ya = pc ? (hq ? d[2].w : d[2].z) : (hq ? d[2].y : d[2].x), yb = pc ? (hq ? d[3].w : d[3].z) : (hq ? d[3].y : d[3].x);
                    const f32x2_pk a01 = __builtin_amdgcn_cvt_pk_f32_fp8((int)ya, false), a23 = __builtin_amdgcn_cvt_pk_f32_fp8((int)ya, true), b01 = __builtin_amdgcn_cvt_pk_f32_fp8((int)yb, false), b23 = __builtin_amdgcn_cvt_pk_f32_fp8((int)yb, true);
                    v[j].x = ALPHA * bf2f(h_lo & 0xffffu) + w0 * a01.x + w1 * b01.x;
                    v[j].y = ALPHA * bf2f(h_lo >> 16) + w0 * a01.y + w1 * b01.y;
                    v[j].z = ALPHA * bf2f(h_hi & 0xffffu) + w0 * a23.x + w1 * b23.x;
                    v[j].w = ALPHA * bf2f(h_hi >> 16) + w0 * a23.y + w1 * b23.y;
                    s1 += (v[j].x + v[j].y) + (v[j].z + v[j].w); s2 += (v[j].x * v[j].x + v[j].y * v[j].y) + (v[j].z * v[j].z + v[j].w * v[j].w);
                }
                s1 = wave_sum(s1); s2 = wave_sum(s2);
                const float mean = s1 * (1.f / D), rstd = 1.f / sqrtf(fmaxf(s2 * (1.f / D) - mean * mean, 0.f) + LN_EPS);
                f32x4 o[4];
#pragma unroll
                for (int j = 0; j < 4; ++j) o[j] = (v[j] - mean) * rstd * gg[j] + bb[j];
                if (lastl) {
                    LAS float* st = (LAS float*)(lds + wave * 16384);
#pragma unroll
                    for (int j = 0; j < 4; ++j) *(LAS f32x4*)(st + 512 * (j >> 1) + 8 * lane + 4 * (j & 1)) = o[j];
                    LDS_WAIT(); asm volatile("" ::: "memory");
                    f32x4 ow[4];
#pragma unroll
                    for (int j = 0; j < 4; ++j) ow[j] = *(LAS const f32x4*)(st + 256 * j + 4 * lane);
#pragma unroll
                    for (int j = 0; j < 4; ++j) __builtin_nontemporal_store(ow[j], (f32x4*)(p.out + (size_t)m * D + 256 * j + 4 * lane));
                    LDS_WAIT(); asm volatile("" ::: "memory");
                } else {
                    bf16_t* hb = (bf16_t*)(p.ws + WS_HB) + (size_t)m * D + 8 * lane;
                    u32x4 w; w.x = pk2(o[0].x, o[0].y); w.y = pk2(o[0].z, o[0].w); w.z = pk2(o[1].x, o[1].y); w.w = pk2(o[1].z, o[1].w); *(u32x4*)hb = w;
                    w.x = pk2(o[2].x, o[2].y); w.y = pk2(o[2].z, o[2].w); w.z = pk2(o[3].x, o[3].y); w.w = pk2(o[3].z, o[3].w); *(u32x4*)(hb + 512) = w;
                }
            }
#undef CMB_ROUTE
#undef CMB_DATA
        }
      }
    }
}

#undef tid
#undef p
static int g_grid = 0;
static void mk_launch(const Ptrs& p, int lo, int hi, int li, hipStream_t stream) {
    Args a{}; a.p = p; a.ph_lo = lo; a.ph_hi = hi; a.li = li; a.pad = 0;
    hipLaunchKernelGGL(mk_fwd, dim3(g_grid), dim3(NWAVES * 64), LDS_BYTES, stream, a);
}

extern "C" void kernel_launch(void* const* d_in, const int* in_sizes, int n_in, void* d_out, int out_size, void* d_ws, size_t ws_size, hipStream_t stream) {
    if (n_in != 17 || out_size != T * D || ws_size < WS_END) { fprintf(stderr, "kernel_launch: unexpected shapes (n_in %d out %d ws %zu)\n", n_in, out_size, ws_size); return; }
    if (g_grid == 0) {
        int dev = 0, cus = 0;
        if (hipGetDevice(&dev) != hipSuccess || hipDeviceGetAttribute(&cus, hipDeviceAttributeMultiprocessorCount, dev) != hipSuccess) { g_grid = -1; return; }
        if (hipFuncSetAttribute((const void*)mk_fwd, hipFuncAttributeMaxDynamicSharedMemorySize, LDS_BYTES) != hipSuccess) { g_grid = -1; return; }
        int per_cu = 0;
        if (hipOccupancyMaxActiveBlocksPerMultiprocessor(&per_cu, (const void*)mk_fwd, NWAVES * 64, LDS_BYTES) != hipSuccess || per_cu < 1) { (void)hipGetLastError(); g_grid = -1; return; }
        g_grid = (cus == 256) ? cus : -1;
    }
    if (g_grid < 0) return;
    Ptrs p{};
    p.x = (const float*)d_in[0]; p.ln0_g = (const float*)d_in[1]; p.ln0_b = (const float*)d_in[2]; p.w_in = (const float*)d_in[3]; p.conv_w = (const float*)d_in[4];
    p.g_conv = (const float*)d_in[5]; p.g_attn = (const float*)d_in[6]; p.w_out = (const float*)d_in[7]; p.ln_mix_g = (const float*)d_in[8]; p.ln_mix_b = (const float*)d_in[9];
    p.router_w = (const float*)d_in[10]; p.router_b = (const float*)d_in[11]; p.w_gate = (const float*)d_in[12]; p.w_up = (const float*)d_in[13]; p.w_down = (const float*)d_in[14];
    p.ln_ffn_g = (const float*)d_in[15]; p.ln_ffn_b = (const float*)d_in[16]; p.out = (float*)d_out; p.ws = (unsigned char*)d_ws;
    (void)hipMemsetAsync((char*)d_ws + WS_CTL, 0, CTL_USED_BYTES, stream);
#if MK_MODE == 0
    for (int ph = 0; ph < N_PHASES; ++ph) mk_launch(p, ph, ph + 1, ph, stream);
#else
    mk_launch(p, 0, N_PHASES, 0, stream);
#endif
}
```
